# Optimizing an MI355X kernel written in HIP

```python
import jax, jax.numpy as jnp
from jax import lax
import numpy as np

D_MODEL = 1024
BATCH = 32
SEQ = 256
DEPTH = 4
DEC_BATCH = 2
DEC_SEQ = 2048
PAST_LEN = 512

GRID_W = 64
N_MIXERS = 2
N_ATTN_LAYERS = (DEPTH + 1) // 2
N_CHUNK_LAYERS = DEPTH // 2
N_HEADS = 8
Q_RANK = 512
KV_RANK = 256
QK_NOPE = 128
QK_ROPE = 64
QK_DIM = QK_NOPE + QK_ROPE
V_DIM = 128
ATTN_WIDTH = N_HEADS * V_DIM
ATTN_IN = Q_RANK + KV_RANK + QK_ROPE + ATTN_WIDTH
AXIS_ROPE = QK_ROPE // 2
ROPE_THETA = 10000.0
Q_BLOCK = 128
CHUNK = 128
MLP_GROUPS = 8
MLP_WIDTH = 2 * D_MODEL
MLP_IN = 3 * MLP_WIDTH
EPS = 1e-6

kernel_name = 'hybrid_mla_chunkmlp_diffusion_step'


def rmsnorm(x, g):
    xf = x.astype(jnp.float32)
    y = xf * lax.rsqrt(jnp.mean(xf * xf, axis=-1, keepdims=True) + EPS)
    return y.astype(x.dtype) * g


def layernorm(x, g, b):
    xf = x.astype(jnp.float32)
    mu = jnp.mean(xf, axis=-1, keepdims=True)
    var = jnp.mean(jnp.square(xf - mu), axis=-1, keepdims=True)
    y = (xf - mu) * lax.rsqrt(var + EPS)
    return y.astype(x.dtype) * g + b


def modulation(cond, w_mod, b_mod):
    m = (jax.nn.silu(cond) @ w_mod + b_mod).reshape(-1, 1, 3 * D_MODEL)
    return m[..., :D_MODEL], m[..., D_MODEL:2 * D_MODEL], m[..., 2 * D_MODEL:]


def axial_rope_tables(n_tokens, dtype):
    rows = n_tokens // GRID_W
    row = jnp.repeat(jnp.arange(rows, dtype=jnp.float32), GRID_W)
    col = jnp.tile(jnp.arange(GRID_W, dtype=jnp.float32), rows)
    inv = 1.0 / (ROPE_THETA ** (jnp.arange(0, AXIS_ROPE, 2, dtype=jnp.float32) / AXIS_ROPE))
    ang = jnp.concatenate([row[:, None] * inv, col[:, None] * inv], axis=-1)
    return jnp.cos(ang).astype(dtype), jnp.sin(ang).astype(dtype)


def _rotate(xa, ca, sa):
    half = xa.shape[-1] // 2
    x1, x2 = xa[..., :half], xa[..., half:]
    return jnp.concatenate([x1 * ca - x2 * sa, x1 * sa + x2 * ca], axis=-1)


def apply_axial_rope(x, cos, sin):
    h = AXIS_ROPE // 2
    xr, xc = x[..., :AXIS_ROPE], x[..., AXIS_ROPE:]
    return jnp.concatenate([_rotate(xr, cos[..., :h], sin[..., :h]),
                            _rotate(xc, cos[..., h:], sin[..., h:])], axis=-1)


def block_attention(q, k, v):
    b, tq, h, dqk = q.shape
    nb = tq // Q_BLOCK
    scale = dqk ** -0.5
    qb = q.reshape(b, nb, Q_BLOCK, h, dqk).swapaxes(0, 1)

    def one_block(qi):
        s = jnp.einsum('bqhd,bkhd->bhqk', qi, k).astype(jnp.float32) * scale
        p = jax.nn.softmax(s, axis=-1).astype(v.dtype)
        return jnp.einsum('bhqk,bkhd->bqhd', p, v)

    out = lax.map(one_block, qb)
    return out.swapaxes(0, 1).reshape(b, tq, h, v.shape[-1])


def mla_project(h, w_in, q_norm_g, kv_norm_g, w_uq):
    b, t, _ = h.shape
    proj = h @ w_in
    c_q = proj[..., :Q_RANK]
    c_kv = proj[..., Q_RANK:Q_RANK + KV_RANK]
    k_pe = proj[..., Q_RANK + KV_RANK:Q_RANK + KV_RANK + QK_ROPE]
    z = proj[..., Q_RANK + KV_RANK + QK_ROPE:]
    q = (rmsnorm(c_q, q_norm_g) @ w_uq).reshape(b, t, N_HEADS, QK_DIM)
    return q, rmsnorm(c_kv, kv_norm_g), k_pe, z


def mla_keys_values(ckv, k_pe, w_ukv):
    b, t, _ = ckv.shape
    kv = (ckv @ w_ukv).reshape(b, t, N_HEADS, QK_NOPE + V_DIM)
    k_nope, v = kv[..., :QK_NOPE], kv[..., QK_NOPE:]
    k_rope = jnp.broadcast_to(k_pe[:, :, None, :], (b, t, N_HEADS, QK_ROPE))
    return jnp.concatenate([k_nope, k_rope], axis=-1), v


def gated_out(o, z, w_o):
    return (o * jax.nn.silu(z)) @ w_o


def chunk_mlp(h, w_in, v_g, v_b, w_s, b_s, w_o):
    b, t, _ = h.shape
    proj = h @ w_in
    uv = jax.nn.gelu(proj[..., :2 * MLP_WIDTH])
    z = proj[..., 2 * MLP_WIDTH:]
    u, v = uv[..., :MLP_WIDTH], uv[..., MLP_WIDTH:]
    v = layernorm(v, v_g, v_b).reshape(b, t // CHUNK, CHUNK, MLP_GROUPS, MLP_WIDTH // MLP_GROUPS)
    s = jnp.einsum('gpq,bcqgd->bcpgd', w_s, v) + b_s.T[:, :, None]
    return gated_out(u * s.reshape(b, t, MLP_WIDTH), z, w_o)


def setup_inputs(seed: int = 0) -> dict:
    key = jax.random.key(seed)
    ks = jax.random.split(key, 24)
    f32 = jnp.float32
    nrm = lambda k, shape, s: jax.random.normal(k, shape, f32) * s
    gain = lambda k, shape: 1.0 + 0.02 * jax.random.normal(k, shape, f32)
    D = D_MODEL
    return {
        'x_prompt': nrm(ks[0], (BATCH, SEQ, D), 1.0),
        'x_sample': nrm(ks[1], (DEC_BATCH, DEC_SEQ, D), 1.0),
        'cache_ckv': nrm(ks[2], (DEC_BATCH, N_ATTN_LAYERS, PAST_LEN, KV_RANK), 1.0),
        'cache_kpe': nrm(ks[3], (DEC_BATCH, N_ATTN_LAYERS, PAST_LEN, QK_ROPE), 1.0),
        'c': nrm(ks[4], (DEC_BATCH, D), 1.0),
        'c_ctx': nrm(ks[5], (D,), 1.0),
        'norm_g': gain(ks[6], (DEPTH, D)),
        'w_mod': nrm(ks[7], (DEPTH, D, 3 * D), 0.5 * D ** -0.5),
        'b_mod': nrm(ks[8], (DEPTH, 3 * D), 0.02),
        'attn_w_in': nrm(ks[9], (N_ATTN_LAYERS, D, ATTN_IN), D ** -0.5),
        'attn_q_norm_g': gain(ks[10], (N_ATTN_LAYERS, Q_RANK)),
        'attn_kv_norm_g': gain(ks[11], (N_ATTN_LAYERS, KV_RANK)),
        'attn_w_uq': nrm(ks[12], (N_ATTN_LAYERS, Q_RANK, N_HEADS * QK_DIM), Q_RANK ** -0.5),
        'attn_w_ukv': nrm(ks[13], (N_ATTN_LAYERS, KV_RANK, N_HEADS * (QK_NOPE + V_DIM)), KV_RANK ** -0.5),
        'attn_w_o': nrm(ks[14], (N_ATTN_LAYERS, ATTN_WIDTH, D), ATTN_WIDTH ** -0.5),
        'mlp_w_in': nrm(ks[15], (N_CHUNK_LAYERS, D, MLP_IN), D ** -0.5),
        'mlp_v_norm_g': gain(ks[16], (N_CHUNK_LAYERS, MLP_WIDTH)),
        'mlp_v_norm_b': nrm(ks[17], (N_CHUNK_LAYERS, MLP_WIDTH), 0.02),
        'mlp_w_s': nrm(ks[18], (N_CHUNK_LAYERS, MLP_GROUPS, CHUNK, CHUNK), CHUNK ** -0.5),
        'mlp_b_s': 1.0 + nrm(ks[19], (N_CHUNK_LAYERS, MLP_GROUPS, CHUNK), 0.02),
        'mlp_w_o': nrm(ks[20], (N_CHUNK_LAYERS, MLP_WIDTH, D), MLP_WIDTH ** -0.5),
        'final_norm_g': gain(ks[21], (D,)),
    }


def reference(x_prompt, x_sample, cache_ckv, cache_kpe, c, c_ctx, norm_g, w_mod, b_mod,
              attn_w_in, attn_q_norm_g, attn_kv_norm_g, attn_w_uq, attn_w_ukv, attn_w_o,
              mlp_w_in, mlp_v_norm_g, mlp_v_norm_b, mlp_w_s, mlp_b_s, mlp_w_o, final_norm_g):
    t_lat = x_sample.shape[1]
    cos, sin = axial_rope_tables(t_lat, x_sample.dtype)
    xc, xl = x_prompt, x_sample
    ckv_out, kpe_out = [], []
    for layer in range(DEPTH):
        sh_c, sc_c, g_c = modulation(c_ctx, w_mod[layer], b_mod[layer])
        sh_l, sc_l, g_l = modulation(c, w_mod[layer], b_mod[layer])
        hc = rmsnorm(xc, norm_g[layer]) * (1.0 + sc_c) + sh_c
        hl = rmsnorm(xl, norm_g[layer]) * (1.0 + sc_l) + sh_l
        if layer % N_MIXERS == 0:
            a = layer // N_MIXERS
            q_c, ckv_c, kpe_c, z_c = mla_project(hc, attn_w_in[a], attn_q_norm_g[a], attn_kv_norm_g[a], attn_w_uq[a])
            k_c, v_c = mla_keys_values(ckv_c, kpe_c, attn_w_ukv[a])
            o_c = block_attention(q_c, k_c, v_c).reshape(hc.shape[0], hc.shape[1], ATTN_WIDTH)
            mix_c = gated_out(o_c, z_c, attn_w_o[a])
            ckv_out.append(ckv_c)
            kpe_out.append(kpe_c)
            q_l, ckv_l, kpe_l, z_l = mla_project(hl, attn_w_in[a], attn_q_norm_g[a], attn_kv_norm_g[a], attn_w_uq[a])
            q_l = jnp.concatenate([q_l[..., :QK_NOPE],
                                   apply_axial_rope(q_l[..., QK_NOPE:], cos[:, None, :], sin[:, None, :])], axis=-1)
            kpe_l = apply_axial_rope(kpe_l, cos, sin)
            k_l, v_l = mla_keys_values(ckv_l, kpe_l, attn_w_ukv[a])
            k_p, v_p = mla_keys_values(cache_ckv[:, a], cache_kpe[:, a], attn_w_ukv[a])
            o_l = block_attention(q_l, jnp.concatenate([k_p, k_l], axis=1),
                                  jnp.concatenate([v_p, v_l], axis=1)).reshape(hl.shape[0], t_lat, ATTN_WIDTH)
            mix_l = gated_out(o_l, z_l, attn_w_o[a])
        else:
            m = layer // N_MIXERS
            mix_c = chunk_mlp(hc, mlp_w_in[m], mlp_v_norm_g[m], mlp_v_norm_b[m], mlp_w_s[m], mlp_b_s[m], mlp_w_o[m])
            mix_l = chunk_mlp(hl, mlp_w_in[m], mlp_v_norm_g[m], mlp_v_norm_b[m], mlp_w_s[m], mlp_b_s[m], mlp_w_o[m])
        xc = xc + g_c * mix_c
        xl = xl + g_l * mix_l
    y_prompt = rmsnorm(xc, final_norm_g)
    y_sample = rmsnorm(xl, final_norm_g)
    new_ckv = jnp.stack(ckv_out, axis=1)
    new_kpe = jnp.stack(kpe_out, axis=1)
    return (y_prompt, y_sample, new_ckv, new_kpe)
```

```cpp
#include <hip/hip_runtime.h>
#include <hip/hip_cooperative_groups.h>
#include <stdint.h>
#include <cstdio>
namespace cg = cooperative_groups;

typedef __attribute__((ext_vector_type(8))) short bf16x8;
typedef __attribute__((ext_vector_type(16))) float f32x16;
typedef unsigned short bf16_t;

#define DEV __device__ __forceinline__

constexpr int D = 1024;
constexpr int T = 12288;
constexpr int TC = 8192;
constexpr int KT = 13312;
constexpr float EPS = 1e-6f;

constexpr size_t SZ_WIN_A = (size_t)2 * 1920 * 1024 * 2;
constexpr size_t SZ_WUQ = (size_t)2 * 1536 * 512 * 2;
constexpr size_t SZ_WUKV = (size_t)2 * 2 * 2048 * 256 * 2;
constexpr size_t SZ_WO_A = (size_t)2 * 1024 * 1024 * 2;
constexpr size_t SZ_WIN_M = (size_t)2 * 6144 * 1024 * 2;
constexpr size_t SZ_WO_M = (size_t)2 * 1024 * 2048 * 2;
constexpr size_t SZ_WS = (size_t)2 * 8 * 128 * 128 * 2;
constexpr size_t SZ_MOD = (size_t)4 * 3 * 3072 * 4;
constexpr size_t SZ_H = (size_t)T * 1024 * 2;
constexpr size_t SZ_CKVK = (size_t)2 * KT * 256 * 2;
constexpr size_t SZ_KPE = (size_t)2 * KT * 64 * 2;
constexpr size_t SZ_STATQ = (size_t)T * 8 * 4;
constexpr size_t SZ_STATKV = (size_t)T * 4 * 4;
constexpr size_t SZ_STATV = (size_t)T * 32 * 2 * 4;

constexpr size_t OFF_WIN_A = 0;
constexpr size_t OFF_WUQ = OFF_WIN_A + SZ_WIN_A;
constexpr size_t OFF_WUKV = OFF_WUQ + SZ_WUQ;
constexpr size_t OFF_WO_A = OFF_WUKV + SZ_WUKV;
constexpr size_t OFF_WIN_M = OFF_WO_A + SZ_WO_A;
constexpr size_t OFF_WO_M = OFF_WIN_M + SZ_WIN_M;
constexpr size_t OFF_WS = OFF_WO_M + SZ_WO_M;
constexpr size_t OFF_MOD = OFF_WS + SZ_WS;
constexpr size_t OFF_H = OFF_MOD + SZ_MOD;
constexpr size_t OFF_CKVK = OFF_H + SZ_H;
constexpr size_t OFF_KPE = OFF_CKVK + SZ_CKVK;
constexpr size_t OFF_STATQ = OFF_KPE + SZ_KPE;
constexpr size_t OFF_STATKV = OFF_STATQ + SZ_STATQ;
constexpr size_t OFF_STATV = OFF_STATKV + SZ_STATKV;
constexpr size_t OFF_UNION = OFF_STATV + SZ_STATV;
constexpr size_t OFF_CQ = OFF_UNION;
constexpr size_t OFF_ZS = OFF_CQ + (size_t)T * 512 * 2;
constexpr size_t OFF_Q = OFF_ZS + (size_t)T * 1024 * 2;
constexpr size_t OFF_KN = OFF_Q + (size_t)T * 1536 * 2;
constexpr size_t OFF_VT = OFF_KN + (size_t)KT * 1024 * 2;
constexpr size_t OFF_UZ = OFF_UNION;
constexpr size_t OFF_GVT = OFF_UZ + (size_t)T * 2048 * 2;

constexpr size_t OFF_BAR = OFF_VT + (size_t)KT * 1024 * 2;
constexpr size_t OFF_MODZ = OFF_BAR + 16384;
constexpr size_t WS_TOTAL = OFF_MODZ + SZ_MOD;

constexpr size_t OUT_CKV = (size_t)T * 1024;
constexpr size_t OUT_KPE = OUT_CKV + (size_t)32 * 2 * 256 * 256;

constexpr int LDS_MAIN = 2 * 2 * 128 * 72 * 2 + 1024;
constexpr int LDS_BYTES = LDS_MAIN + 16;

struct Params {
  const float* in[22];
  float* out;
  char* ws;
  int lo, hi;
};

DEV int opaque_tid() { int t = threadIdx.x; asm volatile("" : "+v"(t)); return t; }
typedef __bf16 hwbf2 __attribute__((ext_vector_type(2)));
typedef float hwf2 __attribute__((ext_vector_type(2)));
DEV unsigned pack2(float a, float b) {
  hwf2 v = {a, b};
  hwbf2 r = __builtin_convertvector(v, hwbf2);
  return *(unsigned*)&r;
}
DEV unsigned short f2bf(float f) { return (unsigned short)(pack2(f, 0.f) & 0xffffu); }
DEV float bf2f(unsigned short b) { return __uint_as_float(((unsigned)b) << 16); }
DEV float bflo(unsigned u) { return __uint_as_float(u << 16); }
DEV float bfhi(unsigned u) { return __uint_as_float(u & 0xffff0000u); }
DEV float silu_f(float x) { return x * __builtin_amdgcn_rcpf(1.f + __expf(-x)); }
DEV float gelu_f(float x) {
  float u = 0.7978845608028654f * (x + 0.044715f * x * x * x);
  return x * __builtin_amdgcn_rcpf(1.f + __expf(-2.f * u));
}
DEV int tok_group(int t) { return t < TC ? 0 : 1 + ((t - TC) >> 11); }
DEV int tok_keyrow(int t) {
  if (t < TC) return t;
  int u = t - TC;
  return TC + (u >> 11) * 2560 + 512 + (u & 2047);
}
DEV float wave_sum(float v) {
  v += __shfl_xor(v, 32);
  v += __shfl_xor(v, 16);
  v += __shfl_xor(v, 8);
  v += __shfl_xor(v, 4);
  v += __shfl_xor(v, 2);
  v += __shfl_xor(v, 1);
  return v;
}
DEV const float* xrow_in(const Params& p, int layer, int t) {
  if (layer == 0) return t < TC ? p.in[0] + (size_t)t * D : p.in[1] + (size_t)(t - TC) * D;
  return p.out + (size_t)t * D;
}

struct NoXf {
  DEV uint4 operator()(uint4 v, int row, int kc) const { return v; }
};

#define GT_LOAD(S, kt_)                                                        \
  {                                                                            \
    const bf16_t* a__ = Ap + (size_t)(kt_) * ksa;                              \
    const bf16_t* w__ = Wp + (size_t)(kt_) * ksw;                              \
    S##a0 = *(const uint4*)(a__);                                              \
    S##a1 = *(const uint4*)(a__ + (size_t)32 * lda);                           \
    S##a2 = *(const uint4*)(a__ + (size_t)64 * lda);                           \
    S##a3 = *(const uint4*)(a__ + (size_t)96 * lda);                           \
    S##w0 = *(const uint4*)(w__);                                              \
    S##w1 = *(const uint4*)(w__ + (size_t)32 * ldw);                           \
    S##w2 = *(const uint4*)(w__ + (size_t)64 * ldw);                           \
    S##w3 = *(const uint4*)(w__ + (size_t)96 * ldw);                           \
  }
#define GT_STORE(S, buf_, kt_)                                              \
  {                                                                         \
    bf16_t* dA = sA + (buf_) * 128 * 72 + lrow * 72 + lkc;                  \
    bf16_t* dW = sW + (buf_) * 128 * 72 + lrow * 72 + lkc;                  \
    *(uint4*)(dA) = S##a0;                                                  \
    *(uint4*)(dA + 32 * 72) = S##a1;                                        \
    *(uint4*)(dA + 64 * 72) = S##a2;                                        \
    *(uint4*)(dA + 96 * 72) = S##a3;                                        \
    *(uint4*)(dW) = xf(S##w0, lrow, (kt_) * 64 + lkc);                      \
    *(uint4*)(dW + 32 * 72) = xf(S##w1, lrow + 32, (kt_) * 64 + lkc);       \
    *(uint4*)(dW + 64 * 72) = xf(S##w2, lrow + 64, (kt_) * 64 + lkc);       \
    *(uint4*)(dW + 96 * 72) = xf(S##w3, lrow + 96, (kt_) * 64 + lkc);       \
  }
#define GT_LDF(dst, p_) dst = *(const bf16x8*)(p_)
#define GT_MMA4(fa0, fa1, fw0, fw1)                                                      \
  acc[0][0] = __builtin_amdgcn_mfma_f32_32x32x16_bf16(fw0, fa0, acc[0][0], 0, 0, 0);     \
  acc[0][1] = __builtin_amdgcn_mfma_f32_32x32x16_bf16(fw1, fa0, acc[0][1], 0, 0, 0);     \
  acc[1][0] = __builtin_amdgcn_mfma_f32_32x32x16_bf16(fw0, fa1, acc[1][0], 0, 0, 0);     \
  acc[1][1] = __builtin_amdgcn_mfma_f32_32x32x16_bf16(fw1, fa1, acc[1][1], 0, 0, 0);
#define GT_COMPUTE(buf_)                                                                   \
  {                                                                                        \
    const bf16_t* cA = sA + (buf_) * 128 * 72 + (wm * 64 + r) * 72 + h * 8;                \
    const bf16_t* cW = sW + (buf_) * 128 * 72 + (wn * 64 + r) * 72 + h * 8;                \
    bf16x8 xa0, xa1, xw0, xw1, ya0, ya1, yw0, yw1;                                         \
    GT_LDF(xa0, cA); GT_LDF(xw0, cW); GT_LDF(xw1, cW + 32 * 72); GT_LDF(xa1, cA + 32 * 72); \
    GT_LDF(ya0, cA + 16); GT_LDF(yw0, cW + 16); GT_LDF(yw1, cW + 32 * 72 + 16); GT_LDF(ya1, cA + 32 * 72 + 16); \
    __builtin_amdgcn_sched_barrier(0);                                                     \
    GT_MMA4(xa0, xa1, xw0, xw1)                                                            \
    __builtin_amdgcn_sched_barrier(0);                                                     \
    GT_LDF(xa0, cA + 32); GT_LDF(xw0, cW + 32); GT_LDF(xw1, cW + 32 * 72 + 32); GT_LDF(xa1, cA + 32 * 72 + 32); \
    __builtin_amdgcn_sched_barrier(0);                                                     \
    GT_MMA4(ya0, ya1, yw0, yw1)                                                            \
    __builtin_amdgcn_sched_barrier(0);                                                     \
    GT_LDF(ya0, cA + 48); GT_LDF(yw0, cW + 48); GT_LDF(yw1, cW + 32 * 72 + 48); GT_LDF(ya1, cA + 32 * 72 + 48); \
    __builtin_amdgcn_sched_barrier(0);                                                     \
    GT_MMA4(xa0, xa1, xw0, xw1)                                                            \
    GT_MMA4(ya0, ya1, yw0, yw1)                                                            \
  }

template <int K, class Epi, class Xf>
DEV void gemm_tile(const bf16_t* __restrict__ A, int lda, const bf16_t* __restrict__ W, int ldw,
                   char* smem, int m0, const Epi& epi, const Xf& xf, size_t ksa = 64, size_t ksw = 64) {
  bf16_t* sA = (bf16_t*)smem;
  bf16_t* sW = sA + 2 * 128 * 72;
  const int tid = opaque_tid(), lane = tid & 63, w = tid >> 6, wm = w & 1, wn = w >> 1;
  const int r = lane & 31, h = lane >> 5;
  f32x16 acc[2][2];
#pragma unroll
  for (int a = 0; a < 2; a++)
#pragma unroll
    for (int b = 0; b < 2; b++)
#pragma unroll
      for (int e = 0; e < 16; e++) acc[a][b][e] = 0.f;
  const int lrow = tid >> 3, lkc = (tid & 7) * 8;
  const bf16_t* Ap = A + (size_t)lrow * lda + lkc;
  const bf16_t* Wp = W + (size_t)lrow * ldw + lkc;
  uint4 Pa0, Pa1, Pa2, Pa3, Pw0, Pw1, Pw2, Pw3;
  uint4 Qa0, Qa1, Qa2, Qa3, Qw0, Qw1, Qw2, Qw3;
  constexpr int nk = K >> 6;
  GT_LOAD(P, 0);
  GT_LOAD(Q, 1);
#pragma unroll 1
  for (int kt = 0; kt < nk; kt += 2) {
    GT_STORE(P, 0, kt);
    __syncthreads();
    GT_LOAD(P, (kt + 2 < nk ? kt + 2 : nk - 2));
    GT_COMPUTE(0);
    GT_STORE(Q, 1, kt + 1);
    __syncthreads();
    GT_LOAD(Q, (kt + 3 < nk ? kt + 3 : nk - 1));
    GT_COMPUTE(1);
  }
  epi(acc[0], m0 + wm * 64 + r, wn, lane);
  epi(acc[1], m0 + wm * 64 + 32 + r, wn, lane);
  __syncthreads();
}

typedef __attribute__((address_space(3))) unsigned lds_u32_t;
#define GG_ISSUE(kt_, buf_)                                                                          \
  {                                                                                                  \
    const bf16_t* a__ = Ag + (size_t)(kt_) * ksa;                                                    \
    const bf16_t* w__ = Wg + (size_t)(kt_) * ksw;                                                    \
    char* d__ = smem + (buf_) * 32768 + w * 1024 + lane * 16;                                        \
    _Pragma("unroll") for (int i_ = 0; i_ < 4; i_++) {                                               \
      __builtin_amdgcn_global_load_lds((const unsigned*)(a__ + (size_t)(32 * i_) * lda),            \
                                       (lds_u32_t*)(d__ + i_ * 4096), 16, 0, 0);                     \
      __builtin_amdgcn_global_load_lds((const unsigned*)(w__ + (size_t)(32 * i_) * ldw),            \
                                       (lds_u32_t*)(d__ + 16384 + i_ * 4096), 16, 0, 0);             \
    }                                                                                                \
  }
#define GG_LDF(dst, base_, kk_) dst = *(const bf16x8*)((base_) + ((((kk_) * 2 + h) ^ fsw) << 4))
#define GG_COMPUTE(buf_)                                                                   \
  {                                                                                        \
    const char* cA = smem + (buf_) * 32768 + (wm * 64 + r) * 128;                          \
    const char* cW = smem + (buf_) * 32768 + 16384 + (wn * 64 + r) * 128;                  \
    bf16x8 xa0, xa1, xw0, xw1, ya0, ya1, yw0, yw1;                                         \
    GG_LDF(xa0, cA, 0); GG_LDF(xw0, cW, 0); GG_LDF(xw1, cW + 4096, 0); GG_LDF(xa1, cA + 4096, 0); \
    GG_LDF(ya0, cA, 1); GG_LDF(yw0, cW, 1); GG_LDF(yw1, cW + 4096, 1); GG_LDF(ya1, cA + 4096, 1); \
    __builtin_amdgcn_sched_barrier(0);                                                     \
    GT_MMA4(xa0, xa1, xw0, xw1)                                                            \
    __builtin_amdgcn_sched_barrier(0);                                                     \
    GG_LDF(xa0, cA, 2); GG_LDF(xw0, cW, 2); GG_LDF(xw1, cW + 4096, 2); GG_LDF(xa1, cA + 4096, 2); \
    __builtin_amdgcn_sched_barrier(0);                                                     \
    GT_MMA4(ya0, ya1, yw0, yw1)                                                            \
    __builtin_amdgcn_sched_barrier(0);                                                     \
    GG_LDF(ya0, cA, 3); GG_LDF(yw0, cW, 3); GG_LDF(yw1, cW + 4096, 3); GG_LDF(ya1, cA + 4096, 3); \
    __builtin_amdgcn_sched_barrier(0);                                                     \
    GT_MMA4(xa0, xa1, xw0, xw1)                                                            \
    GT_MMA4(ya0, ya1, yw0, yw1)                                                            \
  }

template <int K, class Epi>
DEV void gemm_tile_g(const bf16_t* __restrict__ A, int lda, const bf16_t* __restrict__ W, int ldw,
                     char* smem, int m0, const Epi& epi, size_t ksa = 64, size_t ksw = 64) {
  const int tid = opaque_tid(), lane = tid & 63, w = tid >> 6, wm = w & 1, wn = w >> 1;
  const int r = lane & 31, h = lane >> 5;
  const int fsw = (r >> 1) & 7;
  f32x16 acc[2][2];
#pragma unroll
  for (int a = 0; a < 2; a++)
#pragma unroll
    for (int b = 0; b < 2; b++)
#pragma unroll
      for (int e = 0; e < 16; e++) acc[a][b][e] = 0.f;
  const int lrow8 = lane >> 3;
  const int lchunk = (lane & 7) ^ ((((w & 1) << 2) + (lrow8 >> 1)) & 7);
  const bf16_t* Ag = A + (size_t)(w * 8 + lrow8) * lda + lchunk * 8;
  const bf16_t* Wg = W + (size_t)(w * 8 + lrow8) * ldw + lchunk * 8;
  constexpr int nk = K >> 6;
  GG_ISSUE(0, 0);
#pragma unroll 1
  for (int kt = 0; kt < nk; kt += 2) {
    asm volatile("s_waitcnt vmcnt(0)" ::: "memory");
    __syncthreads();
    GG_ISSUE(kt + 1, 1);
    GG_COMPUTE(0);
    asm volatile("s_waitcnt vmcnt(0)" ::: "memory");
    __syncthreads();
    if (kt + 2 < nk) GG_ISSUE(kt + 2, 0);
    GG_COMPUTE(1);
  }
  epi(acc[0], m0 + wm * 64 + r, wn, lane);
  epi(acc[1], m0 + wm * 64 + 32 + r, wn, lane);
  __syncthreads();
}

#define G9_STAGE 20480
#define G9_ISSUE(s_, buf_)                                                                              \
  {                                                                                                     \
    const size_t ko_ = (size_t)((s_) >> 1) * ksa + ((s_) & 1) * 32;                                     \
    const size_t kw_ = (size_t)((s_) >> 1) * ksw + ((s_) & 1) * 32;                                     \
    char* d__ = smem + (buf_) * G9_STAGE + w * 1024 + lane * 16;                                        \
    _Pragma("unroll") for (int i_ = 0; i_ < 3; i_++)                                                    \
      __builtin_amdgcn_global_load_lds((const unsigned*)(Ag + (size_t)(64 * i_) * lda + ko_),          \
                                       (lds_u32_t*)(d__ + i_ * 4096), 16, 0, 0);                        \
    _Pragma("unroll") for (int i_ = 0; i_ < 2; i_++)                                                    \
      __builtin_amdgcn_global_load_lds((const unsigned*)(Wg + (size_t)(64 * i_) * ldw + kw_),          \
                                       (lds_u32_t*)(d__ + 12288 + i_ * 4096), 16, 0, 0);                \
  }

template <int K, class Epi>
DEV void gemm_tile_g192(const bf16_t* __restrict__ A, int lda, const bf16_t* __restrict__ W, int ldw,
                        char* smem, int m0, const Epi& epi, size_t ksa = 64, size_t ksw = 64) {
  const int tid = opaque_tid(), lane = tid & 63, w = tid >> 6, wm = w & 1, wn = w >> 1;
  const int r = lane & 31, h = lane >> 5;
  const int fsw = (r >> 2) & 3;
  f32x16 acc[3][2];
#pragma unroll
  for (int a = 0; a < 3; a++)
#pragma unroll
    for (int b = 0; b < 2; b++)
#pragma unroll
      for (int e = 0; e < 16; e++) acc[a][b][e] = 0.f;
  const int lrow16 = lane >> 2;
  const int lchunk = (lane & 3) ^ ((lane >> 4) & 3);
  const bf16_t* Ag = A + (size_t)(w * 16 + lrow16) * lda + lchunk * 8;
  const bf16_t* Wg = W + (size_t)(w * 16 + lrow16) * ldw + lchunk * 8;
  constexpr int nk = K >> 5;
  asm volatile("s_waitcnt vmcnt(0)" ::: "memory");
  G9_ISSUE(0, 0);
  G9_ISSUE(1, 1);
  int buf = 0;
  const int aoff = (wm * 96 + r) * 64, woff = 12288 + (wn * 64 + r) * 64;
  const int c0 = ((0 + h) ^ fsw) << 4, c1 = ((2 + h) ^ fsw) << 4;
#pragma unroll 1
  for (int s_ = 0; s_ < nk; s_++) {
    if (s_ + 1 < nk) asm volatile("s_waitcnt vmcnt(5)" ::: "memory");
    else asm volatile("s_waitcnt vmcnt(0)" ::: "memory");
    __builtin_amdgcn_s_barrier();
    asm volatile("" ::: "memory");
    if (s_ + 2 < nk) {
      const int nb = buf >= 1 ? buf - 1 : 2;
      G9_ISSUE(s_ + 2, nb);
    }
    const char* cA = smem + buf * G9_STAGE + aoff;
    const char* cW = smem + buf * G9_STAGE + woff;
    {
      bf16x8 a0 = *(const bf16x8*)(cA + c0), a1 = *(const bf16x8*)(cA + 2048 + c0), a2 = *(const bf16x8*)(cA + 4096 + c0);
      bf16x8 w0 = *(const bf16x8*)(cW + c0), w1 = *(const bf16x8*)(cW + 2048 + c0);
      bf16x8 b0 = *(const bf16x8*)(cA + c1), b1 = *(const bf16x8*)(cA + 2048 + c1), b2 = *(const bf16x8*)(cA + 4096 + c1);
      bf16x8 v0 = *(const bf16x8*)(cW + c1), v1 = *(const bf16x8*)(cW + 2048 + c1);
      acc[0][0] = __builtin_amdgcn_mfma_f32_32x32x16_bf16(w0, a0, acc[0][0], 0, 0, 0);
      acc[0][1] = __builtin_amdgcn_mfma_f32_32x32x16_bf16(w1, a0, acc[0][1], 0, 0, 0);
      acc[1][0] = __builtin_amdgcn_mfma_f32_32x32x16_bf16(w0, a1, acc[1][0], 0, 0, 0);
      acc[1][1] = __builtin_amdgcn_mfma_f32_32x32x16_bf16(w1, a1, acc[1][1], 0, 0, 0);
      acc[2][0] = __builtin_amdgcn_mfma_f32_32x32x16_bf16(w0, a2, acc[2][0], 0, 0, 0);
      acc[2][1] = __builtin_amdgcn_mfma_f32_32x32x16_bf16(w1, a2, acc[2][1], 0, 0, 0);
      acc[0][0] = __builtin_amdgcn_mfma_f32_32x32x16_bf16(v0, b0, acc[0][0], 0, 0, 0);
      acc[0][1] = __builtin_amdgcn_mfma_f32_32x32x16_bf16(v1, b0, acc[0][1], 0, 0, 0);
      acc[1][0] = __builtin_amdgcn_mfma_f32_32x32x16_bf16(v0, b1, acc[1][0], 0, 0, 0);
      acc[1][1] = __builtin_amdgcn_mfma_f32_32x32x16_bf16(v1, b1, acc[1][1], 0, 0, 0);
      acc[2][0] = __builtin_amdgcn_mfma_f32_32x32x16_bf16(v0, b2, acc[2][0], 0, 0, 0);
      acc[2][1] = __builtin_amdgcn_mfma_f32_32x32x16_bf16(v1, b2, acc[2][1], 0, 0, 0);
    }
    buf = buf == 2 ? 0 : buf + 1;
  }
#pragma unroll
  for (int ti = 0; ti < 3; ti++) epi(acc[ti], m0 + wm * 96 + ti * 32 + r, wn, lane);
  __syncthreads();
}

DEV void rope_pair(f32x16& a, int pos, int h) {
#pragma unroll
  for (int j = 0; j < 2; j++)
#pragma unroll
    for (int i = 0; i < 4; i++) {
      int f = h * 4 + 8 * j + i;
      float inv = __builtin_amdgcn_exp2f(-(float)f * 0.8304820237218406f);
      float ang = (float)pos * inv;
      float sn, cs;
      __sincosf(ang, &sn, &cs);
      float x1 = a[4 * j + i], x2 = a[4 * (j + 2) + i];
      a[4 * j + i] = x1 * cs - x2 * sn;
      a[4 * (j + 2) + i] = x1 * sn + x2 * cs;
    }
}

DEV int perm_src(int mode, int np) {
  if (mode == 0) {
    if (np < 768) return np;
    if (np < 1792) return np + 64;
    if (np < 1856) return np - 1024;
    return -1;
  } else if (mode == 1) {
    if (np < 4096) {
      int c = np >> 6, rr = np & 63;
      return rr < 32 ? 32 * c + rr : 4096 + 32 * c + (rr - 32);
    }
    return 2048 + (np - 4096);
  }
  return np;
}

DEV void transpose_tile(const float* __restrict__ src, int N, bf16_t* __restrict__ dst, int K, int np0, int k0,
                        int mode, const float* __restrict__ kscale, float* tile, int tm_rows = 0) {
  const int tid = opaque_tid();
  const int tx = tid & 63, ty = tid >> 6;
  const int ns = perm_src(mode, np0 + tx);
  const float vmask = ns >= 0 ? 1.f : 0.f;
  const float* sp = src + (size_t)(k0 + ty) * N + (ns >= 0 ? ns : 0);
  float tv[16];
#pragma unroll
  for (int i = 0; i < 16; i++) tv[i] = sp[(size_t)(4 * i) * N];
  if (kscale) {
    float ks[16];
#pragma unroll
    for (int i = 0; i < 16; i++) ks[i] = kscale[k0 + ty + 4 * i];
#pragma unroll
    for (int i = 0; i < 16; i++) tv[i] *= ks[i];
  }
#pragma unroll
  for (int i = 0; i < 16; i++) tile[(ty + 4 * i) * 65 + tx] = tv[i] * vmask;
  __syncthreads();
  const int rr = tid >> 2, seg = tid & 3;
  unsigned o[8];
#pragma unroll
  for (int e = 0; e < 8; e++) {
    float a = tile[(seg * 16 + 2 * e) * 65 + rr];
    float b = tile[(seg * 16 + 2 * e + 1) * 65 + rr];
    o[e] = pack2(a, b);
  }
  uint4* dp = tm_rows ? (uint4*)(dst + ((size_t)(k0 >> 6) * tm_rows + np0 + rr) * 64 + seg * 16)
                      : (uint4*)(dst + (size_t)(np0 + rr) * K + k0 + seg * 16);
  dp[0] = make_uint4(o[0], o[1], o[2], o[3]);
  dp[1] = make_uint4(o[4], o[5], o[6], o[7]);
  __syncthreads();
}

DEV void transpose_item(const Params& p, int t, float* fl) {
  if (t < 960) {
    int l = t / 480, q = t % 480, nt = q / 16, kt = q % 16;
    transpose_tile(p.in[9] + (size_t)l * 1024 * 1856, 1856, (bf16_t*)(p.ws + OFF_WIN_A) + (size_t)l * 1920 * 1024,
                   1024, nt * 64, kt * 64, 0, nullptr, fl, 1920);
  } else if (t < 960 + 384) {
    t -= 960;
    int l = t / 192, q = t % 192, nt = q / 8, kt = q % 8;
    transpose_tile(p.in[12] + (size_t)l * 512 * 1536, 1536, (bf16_t*)(p.ws + OFF_WUQ) + (size_t)l * 1536 * 512, 512,
                   nt * 64, kt * 64, 2, p.in[10] + l * 512, fl);
  } else if (t < 960 + 384 + 512) {
    t -= 960 + 384;
    int lv = t / 128, q = t % 128, nt = q / 4, kt = q % 4;
    int l = lv >> 1, ver = lv & 1;
    transpose_tile(p.in[13] + (size_t)l * 256 * 2048, 2048, (bf16_t*)(p.ws + OFF_WUKV) + (size_t)lv * 2048 * 256, 256,
                   nt * 64, kt * 64, 2, ver == 0 ? p.in[11] + l * 256 : nullptr, fl);
  } else if (t < 960 + 384 + 512 + 512) {
    t -= 960 + 384 + 512;
    int l = t / 256, q = t % 256, nt = q / 16, kt = q % 16;
    transpose_tile(p.in[14] + (size_t)l * 1024 * 1024, 1024, (bf16_t*)(p.ws + OFF_WO_A) + (size_t)l * 1024 * 1024,
                   1024, nt * 64, kt * 64, 2, nullptr, fl);
  } else if (t < 960 + 384 + 512 + 512 + 3072) {
    t -= 960 + 384 + 512 + 512;
    int l = t / 1536, q = t % 1536, nt = q / 16, kt = q % 16;
    transpose_tile(p.in[15] + (size_t)l * 1024 * 6144, 6144, (bf16_t*)(p.ws + OFF_WIN_M) + (size_t)l * 6144 * 1024,
                   1024, nt * 64, kt * 64, 1, nullptr, fl, 6144);
  } else {
    t -= 960 + 384 + 512 + 512 + 3072;
    int l = t / 512, q = t % 512, nt = q / 32, kt = q % 32;
    transpose_tile(p.in[20] + (size_t)l * 2048 * 1024, 1024, (bf16_t*)(p.ws + OFF_WO_M) + (size_t)l * 1024 * 2048,
                   2048, nt * 64, kt * 64, 2, nullptr, fl);
  }
}

DEV void phase_prep(const Params& p, char* smem) {
  float* fl = (float*)smem;
  const int tid = opaque_tid(), lane = tid & 63, w = tid >> 6;
  constexpr int N_MOD = 384, N_TR = 1184, N_WS = 128, N_CKV = 256, N_KPE = 64;
  constexpr int N_ALL = N_MOD + N_TR + N_WS + N_CKV + N_KPE;
  for (int it = blockIdx.x; it < N_ALL; it += gridDim.x) {
    if (it < N_MOD) {
      const int l = it / 96, ch = (it % 96) >> 2, kq = it & 3;
      float* sc = fl;
      float* red = fl + 3072;
      for (int i = tid; i < 3072; i += 256) {
        int g = i >> 10, k = i & 1023;
        float cv = g == 0 ? p.in[5][k] : p.in[4][(g - 1) * 1024 + k];
        sc[i] = silu_f(cv);
      }
      __syncthreads();
      const float* wm_ = p.in[7] + (size_t)l * 1024 * 3072 + ch * 128 + lane * 2;
      float a0[3] = {0.f, 0.f, 0.f}, a1[3] = {0.f, 0.f, 0.f};
#pragma unroll 16
      for (int k = kq * 256 + w * 64; k < kq * 256 + w * 64 + 64; k++) {
        float2 wv = *(const float2*)(wm_ + (size_t)k * 3072);
#pragma unroll
        for (int g = 0; g < 3; g++) {
          float s = sc[g * 1024 + k];
          a0[g] += s * wv.x;
          a1[g] += s * wv.y;
        }
      }
#pragma unroll
      for (int g = 0; g < 3; g++) {
        red[(w * 3 + g) * 128 + lane * 2] = a0[g];
        red[(w * 3 + g) * 128 + lane * 2 + 1] = a1[g];
      }
      __syncthreads();
      for (int i = tid; i < 384; i += 256) {
        int g = i >> 7, c = i & 127;
        float s = red[(0 * 3 + g) * 128 + c] + red[(1 * 3 + g) * 128 + c] + red[(2 * 3 + g) * 128 + c] +
                  red[(3 * 3 + g) * 128 + c];
        int n = ch * 128 + c;
        atomicAdd(&((float*)(p.ws + OFF_MODZ))[(l * 3 + g) * 3072 + n], s + (kq == 0 ? p.in[8][l * 3072 + n] : 0.f));
      }
      __syncthreads();
    } else if (it < N_MOD + N_TR) {
      const int i = it - N_MOD;
      const int t = i < 480 ? i : i < 672 ? 960 + (i - 480) : i < 928 ? 1344 + (i - 672) : 1856 + (i - 928);
      transpose_item(p, t, fl);
    } else {
      int t = it - N_MOD - N_TR;
      const float* src;
      bf16_t* dst;
      if (t < N_WS) {
        size_t e = (size_t)t * 2048 + tid * 8;
        src = p.in[18] + e;
        dst = (bf16_t*)(p.ws + OFF_WS) + e;
      } else if (t < N_WS + N_CKV) {
        t -= N_WS;
        size_t e = (size_t)t * 2048 + tid * 8;
        int col = e & 255;
        int rowi = (int)(e >> 8);
        int pp = rowi & 511, la = rowi >> 9, a = la & 1, lb = la >> 1;
        src = p.in[2] + e;
        dst = (bf16_t*)(p.ws + OFF_CKVK) + ((size_t)a * KT + TC + lb * 2560 + pp) * 256 + col;
      } else {
        t -= N_WS + N_CKV;
        size_t e = (size_t)t * 2048 + tid * 8;
        int col = e & 63;
        int rowi = (int)(e >> 6);
        int pp = rowi & 511, la = rowi >> 9, a = la & 1, lb = la >> 1;
        src = p.in[3] + e;
        dst = (bf16_t*)(p.ws + OFF_KPE) + ((size_t)a * KT + TC + lb * 2560 + pp) * 64 + col;
      }
      float4 v0 = *(const float4*)src, v1 = *(const float4*)(src + 4);
      *(uint4*)dst = make_uint4(pack2(v0.x, v0.y), pack2(v0.z, v0.w), pack2(v1.x, v1.y), pack2(v1.z, v1.w));
    }
  }
}

DEV void phase_prenorm(const Params& p, int layer) {
  const int tid_ = opaque_tid(); const int lane = tid_ & 63, w = tid_ >> 6;
  bf16_t* H = (bf16_t*)(p.ws + OFF_H);
  const float* mod = (const float*)(p.ws + OFF_MODZ);
  const float* ng = p.in[6] + layer * 1024;
  for (int row = blockIdx.x * 4 + w; row < T; row += gridDim.x * 4) {
    const float* xr = xrow_in(p, layer, row);
    float4 v[4];
    float ss = 0.f;
#pragma unroll
    for (int i = 0; i < 4; i++) {
      v[i] = *(const float4*)(xr + i * 256 + lane * 4);
      ss += v[i].x * v[i].x + v[i].y * v[i].y + v[i].z * v[i].z + v[i].w * v[i].w;
    }
    ss = wave_sum(ss);
    const float rstd = rsqrtf(ss * (1.f / 1024.f) + EPS);
    const float* sh = mod + (layer * 3 + tok_group(row)) * 3072;
    const float* sc = sh + 1024;
#pragma unroll
    for (int i = 0; i < 4; i++) {
      int c = i * 256 + lane * 4;
      float4 g = *(const float4*)(ng + c), s = *(const float4*)(sc + c), b = *(const float4*)(sh + c);
      float o0 = v[i].x * rstd * g.x * (1.f + s.x) + b.x;
      float o1 = v[i].y * rstd * g.y * (1.f + s.y) + b.y;
      float o2 = v[i].z * rstd * g.z * (1.f + s.z) + b.z;
      float o3 = v[i].w * rstd * g.w * (1.f + s.w) + b.w;
      *(uint2*)(H + ((size_t)(c >> 6) * T + row) * 64 + (c & 63)) = make_uint2(pack2(o0, o1), pack2(o2, o3));
    }
  }
}

DEV void phase_attn_inproj(const Params& p, int layer, int a, char* smem) {
  const bf16_t* H = (const bf16_t*)(p.ws + OFF_H);
  const bf16_t* W = (const bf16_t*)(p.ws + OFF_WIN_A) + (size_t)a * 1920 * 1024;
  bf16_t* CQ = (bf16_t*)(p.ws + OFF_CQ);
  bf16_t* ZS = (bf16_t*)(p.ws + OFF_ZS);
  bf16_t* CKVK = (bf16_t*)(p.ws + OFF_CKVK) + (size_t)a * KT * 256;
  bf16_t* KPE = (bf16_t*)(p.ws + OFF_KPE) + (size_t)a * KT * 64;
  float* statq = (float*)(p.ws + OFF_STATQ);
  float* statkv = (float*)(p.ws + OFF_STATKV);
  float* out_kpe = p.out + OUT_KPE;
  for (int j_ = blockIdx.x >> 3; j_ < 12 * 15; j_ += gridDim.x >> 3) {
    const int mt = (blockIdx.x & 7) * 12 + j_ % 12, nt = j_ / 12;
    const int m0 = mt * 128, n0 = nt * 128;
    auto epi = [=](f32x16(&acc)[2], int token, int wn, int lane) {
      const int r = lane & 31, h = lane >> 5;
      {
        if (nt < 6) {
          float ss = 0.f;
          bf16_t* dst = nt < 4 ? CQ + (size_t)token * 512 + n0 + wn * 64
                               : CKVK + (size_t)tok_keyrow(token) * 256 + (n0 - 512) + wn * 64;
#pragma unroll
          for (int fi = 0; fi < 2; fi++)
#pragma unroll
            for (int j = 0; j < 4; j++) {
              float v0 = acc[fi][4 * j], v1 = acc[fi][4 * j + 1], v2 = acc[fi][4 * j + 2],
                    v3 = acc[fi][4 * j + 3];
              ss += v0 * v0 + v1 * v1 + v2 * v2 + v3 * v3;
              *(uint2*)(dst + fi * 32 + h * 4 + 8 * j) = make_uint2(pack2(v0, v1), pack2(v2, v3));
            }
          ss += __shfl_xor(ss, 32);
          if (h == 0) {
            if (nt < 4) statq[token * 8 + nt * 2 + wn] = ss;
            else statkv[token * 4 + (nt - 4) * 2 + wn] = ss;
          }
        } else if (nt < 14) {
          bf16_t* dst = ZS + (size_t)token * 1024 + (n0 - 768) + wn * 64;
#pragma unroll
          for (int fi = 0; fi < 2; fi++)
#pragma unroll
            for (int j = 0; j < 4; j++) {
              float v0 = silu_f(acc[fi][4 * j]), v1 = silu_f(acc[fi][4 * j + 1]),
                    v2 = silu_f(acc[fi][4 * j + 2]), v3 = silu_f(acc[fi][4 * j + 3]);
              *(uint2*)(dst + fi * 32 + h * 4 + 8 * j) = make_uint2(pack2(v0, v1), pack2(v2, v3));
            }
        } else if (wn == 0) {
          if (token < TC) {
            float* od = out_kpe + ((size_t)((token >> 8) * 2 + a) * 256 + (token & 255)) * 64;
#pragma unroll
            for (int fi = 0; fi < 2; fi++)
#pragma unroll
              for (int j = 0; j < 4; j++)
                *(float4*)(od + fi * 32 + h * 4 + 8 * j) =
                    make_float4(acc[fi][4 * j], acc[fi][4 * j + 1], acc[fi][4 * j + 2], acc[fi][4 * j + 3]);
          } else {
            int s = (token - TC) & 2047;
            rope_pair(acc[0], s >> 6, h);
            rope_pair(acc[1], s & 63, h);
          }
          bf16_t* dst = KPE + (size_t)tok_keyrow(token) * 64;
#pragma unroll
          for (int fi = 0; fi < 2; fi++)
#pragma unroll
            for (int j = 0; j < 4; j++)
              *(uint2*)(dst + fi * 32 + h * 4 + 8 * j) =
                  make_uint2(pack2(acc[fi][4 * j], acc[fi][4 * j + 1]), pack2(acc[fi][4 * j + 2], acc[fi][4 * j + 3]));
        }
      }
    };
    gemm_tile_g<1024>(H + (size_t)m0 * 64, 64, W + (size_t)n0 * 64, 64, smem, m0, epi, (size_t)T * 64, (size_t)1920 * 64);
  }
}

DEV void phase_attn_up(const Params& p, int layer, int a, char* smem) {
  const bf16_t* CQ = (const bf16_t*)(p.ws + OFF_CQ);
  const bf16_t* WUQ = (const bf16_t*)(p.ws + OFF_WUQ) + (size_t)a * 1536 * 512;
  const bf16_t* CKVK = (const bf16_t*)(p.ws + OFF_CKVK) + (size_t)a * KT * 256;
  bf16_t* Q = (bf16_t*)(p.ws + OFF_Q);
  bf16_t* KN = (bf16_t*)(p.ws + OFF_KN);
  bf16_t* VT = (bf16_t*)(p.ws + OFF_VT);
  const float* statq = (const float*)(p.ws + OFF_STATQ);
  const float* statkv = (const float*)(p.ws + OFF_STATKV);
  constexpr int NQ = 96 * 12, NKV = 104 * 16, NCK = 128;
  const float qscale = 0.07216878364870322f * 1.4426950408889634f;
  const int xcd_ = blockIdx.x & 7;
  for (int t = blockIdx.x >> 3; t < (NQ + NKV + NCK) / 8; t += gridDim.x >> 3) {
    if (t < NQ / 8) {
      const int mt = xcd_ * 12 + t % 12, nt = t / 12;
      const int m0 = mt * 128, n0 = nt * 128;
      auto epi = [=](f32x16(&acc)[2], int token, int wn, int lane) {
        const int r = lane & 31, h = lane >> 5;
        const int b64 = (n0 + wn * 64) >> 6;
        const bool ropeblk = (b64 % 3) == 2;
        {
          const float4 s0 = *(const float4*)(statq + token * 8), s1 = *(const float4*)(statq + token * 8 + 4);
          const float ss = s0.x + s0.y + s0.z + s0.w + s1.x + s1.y + s1.z + s1.w;
          const float sc = rsqrtf(ss * (1.f / 512.f) + EPS) * qscale;
#pragma unroll
          for (int fi = 0; fi < 2; fi++)
#pragma unroll
            for (int e = 0; e < 16; e++) acc[fi][e] *= sc;
          if (ropeblk && token >= TC) {
            int s = (token - TC) & 2047;
            rope_pair(acc[0], s >> 6, h);
            rope_pair(acc[1], s & 63, h);
          }
          bf16_t* dst = Q + (size_t)token * 1536 + n0 + wn * 64;
#pragma unroll
          for (int fi = 0; fi < 2; fi++)
#pragma unroll
            for (int j = 0; j < 4; j++)
              *(uint2*)(dst + fi * 32 + h * 4 + 8 * j) =
                  make_uint2(pack2(acc[fi][4 * j], acc[fi][4 * j + 1]), pack2(acc[fi][4 * j + 2], acc[fi][4 * j + 3]));
        }
      };
      gemm_tile_g<512>(CQ + (size_t)m0 * 512, 512, WUQ + (size_t)n0 * 512, 512, smem, m0, epi);
    } else if (t < (NQ + NKV) / 8) {
      const int tt = t - NQ / 8;
      const int mt = xcd_ * 13 + tt % 13, nt = tt / 13;
      const int m0 = mt * 128, n0 = nt * 128;
      const bool isCache = (m0 >= TC) && (((m0 - TC) % 2560) < 512);
      const bf16_t* WUKV = (const bf16_t*)(p.ws + OFF_WUKV) + (size_t)(a * 2 + (isCache ? 1 : 0)) * 2048 * 256;
      const int head = nt >> 1;
      auto epi = [=](f32x16(&acc)[2], int token, int wn, int lane) {
        const int r = lane & 31, h = lane >> 5;
        {
          const int krow = token;
          float sc = 1.f;
          if (!isCache) {
            int token = krow;
            if (krow >= TC) {
              int u = krow - TC;
              int lb = u / 2560;
              token = TC + lb * 2048 + (u - lb * 2560 - 512);
            }
            const float4 s0 = *(const float4*)(statkv + token * 4);
            sc = rsqrtf((s0.x + s0.y + s0.z + s0.w) * (1.f / 256.f) + EPS);
          }
          if ((nt & 1) == 0) {
            bf16_t* dst = KN + (size_t)krow * 1024 + head * 128 + wn * 64;
#pragma unroll
            for (int fi = 0; fi < 2; fi++)
#pragma unroll
              for (int j = 0; j < 4; j++)
                *(uint2*)(dst + fi * 32 + h * 4 + 8 * j) =
                    make_uint2(pack2(acc[fi][4 * j] * sc, acc[fi][4 * j + 1] * sc),
                               pack2(acc[fi][4 * j + 2] * sc, acc[fi][4 * j + 3] * sc));
          } else {
            bf16_t* dst = VT + (size_t)(head * 128 + wn * 64) * KT + krow;
#pragma unroll
            for (int fi = 0; fi < 2; fi++)
#pragma unroll
              for (int e = 0; e < 16; e++) {
                int dv = fi * 32 + h * 4 + 8 * (e >> 2) + (e & 3);
                dst[(size_t)dv * KT] = f2bf(acc[fi][e] * sc);
              }
          }
        }
      };
      gemm_tile_g<256>(CKVK + (size_t)m0 * 256, 256, WUKV + (size_t)n0 * 256, 256, smem, m0, epi);
    } else {
      const int tt = xcd_ * 16 + (t - (NQ + NKV) / 8);
      const float* gk = p.in[11] + a * 256;
      float* oc = p.out + OUT_CKV;
      for (int i = threadIdx.x; i < 64 * 32; i += 256) {
        int token = tt * 64 + (i >> 5), c = (i & 31) * 8;
        const float4 s0 = *(const float4*)(statkv + token * 4);
        const float sc = rsqrtf((s0.x + s0.y + s0.z + s0.w) * (1.f / 256.f) + EPS);
        uint4 v = *(const uint4*)(CKVK + (size_t)token * 256 + c);
        float4 g0 = *(const float4*)(gk + c), g1 = *(const float4*)(gk + c + 4);
        float* od = oc + ((size_t)((token >> 8) * 2 + a) * 256 + (token & 255)) * 256 + c;
        *(float4*)od = make_float4(bflo(v.x) * sc * g0.x, bfhi(v.x) * sc * g0.y, bflo(v.y) * sc * g0.z, bfhi(v.y) * sc * g0.w);
        *(float4*)(od + 4) = make_float4(bflo(v.z) * sc * g1.x, bfhi(v.z) * sc * g1.y, bflo(v.w) * sc * g1.z, bfhi(v.w) * sc * g1.w);
      }
    }
  }
}

DEV void phase_attn_core(const Params& p, int a, char* smem) {
  const bf16_t* Q = (const bf16_t*)(p.ws + OFF_Q);
  const bf16_t* KN = (const bf16_t*)(p.ws + OFF_KN);
  const bf16_t* VT = (const bf16_t*)(p.ws + OFF_VT);
  const bf16_t* KPE = (const bf16_t*)(p.ws + OFF_KPE) + (size_t)a * KT * 64;
  bf16_t* ZS = (bf16_t*)(p.ws + OFF_ZS);
  bf16_t* sK = (bf16_t*)smem;
  bf16_t* sV = sK + 64 * 200;
  const int tid = opaque_tid(), lane = tid & 63, w = tid >> 6, r = lane & 31, h = lane >> 5;
  const int qh = w;
  const int xcd = blockIdx.x & 7, nloc = gridDim.x >> 3, local = blockIdx.x >> 3, nheavy = nloc >> 1;
  const bool heavyblk = local < nheavy;
  const int istart = heavyblk ? local : local - nheavy;
  const int istep = heavyblk ? nheavy : nloc - nheavy;
  const int iend = heavyblk ? 32 : 64;
  for (int item = istart; item < iend; item += istep) {
    int head, tq0, kr0, nkt;
    if (heavyblk) {
      int pair = xcd * 2 + (item >> 4);
      int lb = pair >> 3;
      head = pair & 7;
      tq0 = TC + lb * 2048 + (item & 15) * 128;
      kr0 = TC + lb * 2560;
      nkt = 40;
    } else {
      int pair = xcd * 32 + (item >> 1);
      int b = pair >> 3;
      head = pair & 7;
      tq0 = b * 256 + (item & 1) * 128;
      kr0 = b * 256;
      nkt = 4;
    }
    bf16x8 qf[12];
    {
      const bf16_t* qp = Q + (size_t)(tq0 + qh * 32 + r) * 1536 + head * 192 + h * 8;
#pragma unroll
      for (int kk = 0; kk < 12; kk++) qf[kk] = *(const bf16x8*)(qp + kk * 16);
    }
    f32x16 o[4];
#pragma unroll
    for (int d = 0; d < 4; d++)
#pragma unroll
      for (int e = 0; e < 16; e++) o[d][e] = 0.f;
    float m = -1e30f, l = 0.f;
    uint4 rk0, rk1, rk2, rk3, rk4, rk5, rv0, rv1, rv2, rv3;
    const int krow_ = tid >> 2, kpart = tid & 3, vrow = tid >> 1, vhalf = tid & 1;
    const bf16_t* kn_p = KN + (size_t)(kr0 + krow_) * 1024 + head * 128 + kpart * 32;
    const bf16_t* kpe_p = KPE + (size_t)(kr0 + krow_) * 64 + kpart * 16;
    const bf16_t* vt_p = VT + (size_t)(head * 128 + vrow) * KT + kr0 + vhalf * 32;
#define GLOADK(t_)                                                      \
  {                                                                     \
    const bf16_t* a_ = kn_p + (size_t)(t_) * 64 * 1024;                 \
    const bf16_t* b_ = kpe_p + (size_t)(t_) * 64 * 64;                  \
    rk0 = *(const uint4*)(a_);                                          \
    rk1 = *(const uint4*)(a_ + 8);                                      \
    rk2 = *(const uint4*)(a_ + 16);                                     \
    rk3 = *(const uint4*)(a_ + 24);                                     \
    rk4 = *(const uint4*)(b_);                                          \
    rk5 = *(const uint4*)(b_ + 8);                                      \
  }
#define GLOADV(t_)                                                      \
  {                                                                     \
    const bf16_t* a_ = vt_p + (t_) * 64;                                \
    rv0 = *(const uint4*)(a_);                                          \
    rv1 = *(const uint4*)(a_ + 8);                                      \
    rv2 = *(const uint4*)(a_ + 16);                                     \
    rv3 = *(const uint4*)(a_ + 24);                                     \
  }
    GLOADK(0);
    GLOADV(0);
    for (int t = 0; t < nkt; t++) {
      __syncthreads();
      {
        bf16_t* d_ = sK + krow_ * 200 + kpart * 32;
        *(uint4*)(d_) = rk0;
        *(uint4*)(d_ + 8) = rk1;
        *(uint4*)(d_ + 16) = rk2;
        *(uint4*)(d_ + 24) = rk3;
        bf16_t* e_ = sK + krow_ * 200 + 128 + kpart * 16;
        *(uint4*)(e_) = rk4;
        *(uint4*)(e_ + 8) = rk5;
        bf16_t* f_ = sV + vrow * 72 + vhalf * 32;
        *(uint4*)(f_) = rv0;
        *(uint4*)(f_ + 8) = rv1;
        *(uint4*)(f_ + 16) = rv2;
        *(uint4*)(f_ + 24) = rv3;
      }
      __syncthreads();
      if (t + 1 < nkt) GLOADK(t + 1);
      f32x16 sv[2];
#pragma unroll
      for (int ks = 0; ks < 2; ks++) {
#pragma unroll
        for (int e = 0; e < 16; e++) sv[ks][e] = 0.f;
        const bf16_t* kp = sK + (ks * 32 + r) * 200 + h * 8;
#pragma unroll
        for (int kk = 0; kk < 12; kk++) {
          bf16x8 kf = *(const bf16x8*)(kp + kk * 16);
          sv[ks] = __builtin_amdgcn_mfma_f32_32x32x16_bf16(kf, qf[kk], sv[ks], 0, 0, 0);
        }
      }
      float mx = sv[0][0];
#pragma unroll
      for (int e = 1; e < 16; e++) mx = fmaxf(mx, sv[0][e]);
#pragma unroll
      for (int e = 0; e < 16; e++) mx = fmaxf(mx, sv[1][e]);
      mx = fmaxf(mx, __shfl_xor(mx, 32));
      const float mnew = fmaxf(m, mx);
      const float alpha = __builtin_amdgcn_exp2f(m - mnew);
      m = mnew;
      float ps = 0.f;
#pragma unroll
      for (int ks = 0; ks < 2; ks++)
#pragma unroll
        for (int e = 0; e < 16; e++) {
          float pv = __builtin_amdgcn_exp2f(sv[ks][e] - mnew);
          sv[ks][e] = pv;
          ps += pv;
        }
      l = l * alpha + ps;
      if (t + 1 < nkt) GLOADV(t + 1);
      if (!__all(alpha == 1.f)) {
#pragma unroll
        for (int d = 0; d < 4; d++)
#pragma unroll
          for (int e = 0; e < 16; e++) o[d][e] *= alpha;
      }
#pragma unroll
      for (int ks = 0; ks < 2; ks++)
#pragma unroll
        for (int s2 = 0; s2 < 2; s2++) {
          union { bf16x8 v; unsigned u[4]; } pf;
#pragma unroll
          for (int e = 0; e < 4; e++) pf.u[e] = pack2(sv[ks][8 * s2 + 2 * e], sv[ks][8 * s2 + 2 * e + 1]);
#pragma unroll
          for (int d = 0; d < 4; d++) {
            const bf16_t* vp = sV + (d * 32 + r) * 72 + ks * 32 + 16 * s2 + 4 * h;
            union { bf16x8 v; uint2 u[2]; } vf;
            vf.u[0] = *(const uint2*)vp;
            vf.u[1] = *(const uint2*)(vp + 8);
            o[d] = __builtin_amdgcn_mfma_f32_32x32x16_bf16(vf.v, pf.v, o[d], 0, 0, 0);
          }
        }
    }
    {
    l += __shfl_xor(l, 32);
    const float inv = 1.f / l;
    bf16_t* zp = ZS + (size_t)(tq0 + qh * 32 + r) * 1024 + head * 128;
#pragma unroll
    for (int d = 0; d < 4; d++)
#pragma unroll
      for (int j = 0; j < 4; j++) {
        bf16_t* ap = zp + d * 32 + h * 4 + 8 * j;
        uint2 z = *(const uint2*)ap;
        float v0 = o[d][4 * j] * inv * bflo(z.x), v1 = o[d][4 * j + 1] * inv * bfhi(z.x);
        float v2 = o[d][4 * j + 2] * inv * bflo(z.y), v3 = o[d][4 * j + 3] * inv * bfhi(z.y);
        *(uint2*)ap = make_uint2(pack2(v0, v1), pack2(v2, v3));
      }
    }
  }
  if (a == 0 && !heavyblk) {
    __syncthreads();
    const int nlight = 8 * (nloc - nheavy), rank = xcd + 8 * (local - nheavy);
    for (int i = rank; i < 5280; i += nlight) {
      const int t = i < 480 ? 480 + i : i < 672 ? 1152 + (i - 480) : i < 928 ? 1600 + (i - 672)
                                    : i < 1184 ? 2112 + (i - 928) : 2368 + (i - 1184);
      transpose_item(p, t, (float*)smem);
    }
  }
}

template <int K>
DEV void phase_outproj(const Params& p, int layer, const bf16_t* A, const bf16_t* W, char* smem) {
  const float* mod = (const float*)(p.ws + OFF_MODZ);
  const float* x0 = layer == 0 ? p.in[0] : p.out;
  const float* x1 = layer == 0 ? p.in[1] : p.out + (size_t)TC * D;
  float* xout = p.out;
  for (int j_ = blockIdx.x >> 3; j_ < 8 * 8; j_ += gridDim.x >> 3) {
    const int mt = (blockIdx.x & 7) * 8 + (j_ & 7), nt = j_ >> 3;
    const int m0 = mt * 192, n0 = nt * 128;
    auto epi = [=](f32x16(&acc)[2], int token, int wn, int lane) {
      const int r = lane & 31, h = lane >> 5;
      {
        const float* gate = mod + (layer * 3 + tok_group(token)) * 3072 + 2048 + n0 + wn * 64;
        const float* xi = (token < TC ? x0 + (size_t)token * D : x1 + (size_t)(token - TC) * D) + n0 + wn * 64;
        float* xo = xout + (size_t)token * D + n0 + wn * 64;
#pragma unroll
        for (int fi = 0; fi < 2; fi++)
#pragma unroll
          for (int j = 0; j < 4; j++) {
            int c = fi * 32 + h * 4 + 8 * j;
            float4 g = *(const float4*)(gate + c), x = *(const float4*)(xi + c);
            *(float4*)(xo + c) = make_float4(x.x + g.x * acc[fi][4 * j], x.y + g.y * acc[fi][4 * j + 1],
                                             x.z + g.z * acc[fi][4 * j + 2], x.w + g.w * acc[fi][4 * j + 3]);
          }
      }
    };
    gemm_tile_g192<K>(A + (size_t)m0 * K, K, W + (size_t)n0 * K, K, smem, m0, epi);
  }
}

DEV void phase_mlp_inproj(const Params& p, int mi, char* smem) {
  const bf16_t* H = (const bf16_t*)(p.ws + OFF_H);
  const bf16_t* W = (const bf16_t*)(p.ws + OFF_WIN_M) + (size_t)mi * 6144 * 1024;
  bf16_t* UZ = (bf16_t*)(p.ws + OFF_UZ);
  bf16_t* GVT = (bf16_t*)(p.ws + OFF_GVT);
  float* statv = (float*)(p.ws + OFF_STATV);
  for (int j_ = blockIdx.x >> 3; j_ < 12 * 48; j_ += gridDim.x >> 3) {
    const int mt = (blockIdx.x & 7) * 12 + j_ % 12, nt = j_ / 12;
    const int m0 = mt * 128, n0 = nt * 128;
    auto epi = [=](f32x16(&acc)[2], int token, int wn, int lane) {
      const int r = lane & 31, h = lane >> 5;
      {
        if (nt < 32) {
          bf16_t* dst = UZ + (size_t)token * 2048 + nt * 64 + wn * 32;
#pragma unroll
          for (int j = 0; j < 4; j++) {
            float v0 = gelu_f(acc[0][4 * j]) * silu_f(acc[1][4 * j]);
            float v1 = gelu_f(acc[0][4 * j + 1]) * silu_f(acc[1][4 * j + 1]);
            float v2 = gelu_f(acc[0][4 * j + 2]) * silu_f(acc[1][4 * j + 2]);
            float v3 = gelu_f(acc[0][4 * j + 3]) * silu_f(acc[1][4 * j + 3]);
            *(uint2*)(dst + h * 4 + 8 * j) = make_uint2(pack2(v0, v1), pack2(v2, v3));
          }
        } else {
          const int ch0 = (nt - 32) * 128 + wn * 64;
          bf16_t* dst = GVT + ((size_t)(token >> 7) * 2048 + ch0) * 128 + (token & 127);
          float s1 = 0.f, s2 = 0.f;
#pragma unroll
          for (int fi = 0; fi < 2; fi++)
#pragma unroll
            for (int e = 0; e < 16; e++) {
              float g = gelu_f(acc[fi][e]);
              s1 += g;
              s2 += g * g;
              int ch = fi * 32 + h * 4 + 8 * (e >> 2) + (e & 3);
              dst[(size_t)ch * 128] = f2bf(g);
            }
          s1 += __shfl_xor(s1, 32);
          s2 += __shfl_xor(s2, 32);
          if (h == 0) *(float2*)(statv + ((size_t)token * 32 + (nt - 32) * 2 + wn) * 2) = make_float2(s1, s2);
        }
      }
    };
    gemm_tile_g<1024>(H + (size_t)m0 * 64, 64, W + (size_t)n0 * 64, 64, smem, m0, epi, (size_t)T * 64, (size_t)6144 * 64);
  }
}

struct LnXf {
  const float* smu;
  const float* vg;
  const float* vb;
  DEV uint4 operator()(uint4 v, int row, int kc) const {
    const float g = vg[row], b = vb[row];
    const float* mu = smu + kc;
    const float* rs = smu + 128 + kc;
    float f0 = (bflo(v.x) - mu[0]) * rs[0] * g + b, f1 = (bfhi(v.x) - mu[1]) * rs[1] * g + b;
    float f2 = (bflo(v.y) - mu[2]) * rs[2] * g + b, f3 = (bfhi(v.y) - mu[3]) * rs[3] * g + b;
    float f4 = (bflo(v.z) - mu[4]) * rs[4] * g + b, f5 = (bfhi(v.z) - mu[5]) * rs[5] * g + b;
    float f6 = (bflo(v.w) - mu[6]) * rs[6] * g + b, f7 = (bfhi(v.w) - mu[7]) * rs[7] * g + b;
    return make_uint4(pack2(f0, f1), pack2(f2, f3), pack2(f4, f5), pack2(f6, f7));
  }
};

DEV void phase_mlp_spatial(const Params& p, int mi, char* smem) {
  const bf16_t* WS = (const bf16_t*)(p.ws + OFF_WS) + (size_t)mi * 8 * 128 * 128;
  const bf16_t* GVT = (const bf16_t*)(p.ws + OFF_GVT);
  bf16_t* UZ = (bf16_t*)(p.ws + OFF_UZ);
  const float* statv = (const float*)(p.ws + OFF_STATV);
  float* smu = (float*)(smem + 2 * 2 * 128 * 72 * 2);
  for (int t = blockIdx.x; t < 96 * 16; t += gridDim.x) {
    const int c = t >> 4, g = (t >> 1) & 7, hf = t & 1;
    if (threadIdx.x < 128) {
      const float* sp = statv + (size_t)(c * 128 + threadIdx.x) * 64;
      float s1 = 0.f, s2 = 0.f;
#pragma unroll
      for (int i = 0; i < 16; i++) {
        float4 v = *(const float4*)(sp + 4 * i);
        s1 += v.x + v.z;
        s2 += v.y + v.w;
      }
      float mu = s1 * (1.f / 2048.f);
      float var = s2 * (1.f / 2048.f) - mu * mu;
      smu[threadIdx.x] = mu;
      smu[128 + threadIdx.x] = rsqrtf(fmaxf(var, 0.f) + EPS);
    }
    __syncthreads();
    const int ch0 = g * 256 + hf * 128;
    LnXf xf{smu, p.in[16] + mi * 2048 + ch0, p.in[17] + mi * 2048 + ch0};
    const float* bs = p.in[19] + (mi * 8 + g) * 128;
    auto epi = [=](f32x16(&acc)[2], int token, int wn, int lane) {
      const int r = lane & 31, h = lane >> 5;
      {
        const int pt = token;
        const float b = bs[pt];
        bf16_t* dst = UZ + (size_t)(c * 128 + pt) * 2048 + ch0 + wn * 64;
#pragma unroll
        for (int fi = 0; fi < 2; fi++)
#pragma unroll
          for (int j = 0; j < 4; j++) {
            bf16_t* ap = dst + fi * 32 + h * 4 + 8 * j;
            uint2 u = *(const uint2*)ap;
            float v0 = bflo(u.x) * (acc[fi][4 * j] + b), v1 = bfhi(u.x) * (acc[fi][4 * j + 1] + b);
            float v2 = bflo(u.y) * (acc[fi][4 * j + 2] + b), v3 = bfhi(u.y) * (acc[fi][4 * j + 3] + b);
            *(uint2*)ap = make_uint2(pack2(v0, v1), pack2(v2, v3));
          }
      }
    };
    gemm_tile<128>(WS + (size_t)g * 128 * 128, 128, GVT + ((size_t)c * 2048 + ch0) * 128, 128, smem, 0, epi, xf);
  }
}

DEV void phase_final(const Params& p) {
  const int tid_ = opaque_tid(); const int lane = tid_ & 63, w = tid_ >> 6;
  const float* fg = p.in[21];
  for (int row = blockIdx.x * 4 + w; row < T; row += gridDim.x * 4) {
    float* xr = p.out + (size_t)row * D;
    float4 v[4];
    float ss = 0.f;
#pragma unroll
    for (int i = 0; i < 4; i++) {
      v[i] = *(const float4*)(xr + i * 256 + lane * 4);
      ss += v[i].x * v[i].x + v[i].y * v[i].y + v[i].z * v[i].z + v[i].w * v[i].w;
    }
    ss = wave_sum(ss);
    const float rstd = rsqrtf(ss * (1.f / 1024.f) + EPS);
#pragma unroll
    for (int i = 0; i < 4; i++) {
      int c = i * 256 + lane * 4;
      float4 g = *(const float4*)(fg + c);
      *(float4*)(xr + c) = make_float4(v[i].x * rstd * g.x, v[i].y * rstd * g.y, v[i].z * rstd * g.z, v[i].w * rstd * g.w);
    }
  }
}

#define XB_TMO      128
#define XB_XCNT(j)  (256  + 64 * (j))
#define XB_XSUB(j)  (1280 + 64 * (j))
#define XB_XGEN(j)  (2304 + 64 * (j))
#define XB_TOP      3328
#define XB_TOPGEN   3392
#define XCD_BAR_WORDS 3456
#define XB_SPIN_CAP (1u << 18)
#define LAS __attribute__((address_space(3)))

__device__ __forceinline__ unsigned xb_ld(unsigned* p)              { return __hip_atomic_load(p, __ATOMIC_RELAXED, __HIP_MEMORY_SCOPE_AGENT); }
__device__ __forceinline__ unsigned xb_add(unsigned* p, unsigned v) { return __hip_atomic_fetch_add(p, v, __ATOMIC_RELAXED, __HIP_MEMORY_SCOPE_AGENT); }
__device__ __forceinline__ unsigned xb_xcc_id() { return (unsigned)__builtin_amdgcn_s_getreg((3 << 11) | 20) & 0xFu; }
#define XB_SPIN(cond, bar) do { unsigned _sp = 0; while (cond) { __builtin_amdgcn_s_sleep(1); \
    if ((++_sp & 255u) == 0u) { if (xb_ld(&(bar)[XB_TMO])) break; if (_sp > XB_SPIN_CAP) { atomicAdd(&(bar)[XB_TMO], 1u); break; } } } } while (0)

struct XcdBarrier {
    unsigned* bar; unsigned x;
    volatile LAS unsigned* st;
};

__device__ __forceinline__ XcdBarrier xcd_barrier_post(unsigned* bar, volatile LAS unsigned* st) {
    XcdBarrier b; b.bar = bar; b.x = xb_xcc_id(); b.st = st;
    if (threadIdx.x == 0) (void)xb_add(&bar[XB_XCNT(b.x)], 1u);
    return b;
}
__device__ __forceinline__ void xcd_barrier_complete(unsigned* bar, unsigned x, unsigned& nloc, unsigned& nx) {
    const unsigned G = gridDim.x * gridDim.y * gridDim.z;
    unsigned sum, cnt, mine, sp = 0u;
    for (;;) {
        sum = 0u; cnt = 0u; mine = 0u;
#pragma unroll
        for (unsigned j = 0; j < 16; ++j) { const unsigned c = xb_ld(&bar[XB_XCNT(j)]); sum += c; cnt += (c > 0u) ? 1u : 0u; mine = (j == x) ? c : mine; }
        if (sum == G) break;
        __builtin_amdgcn_s_sleep(1);
        if ((++sp & 255u) == 0u) { if (xb_ld(&bar[XB_TMO])) break; if (sp > XB_SPIN_CAP) { atomicAdd(&bar[XB_TMO], 1u); break; } }
    }
    nloc = mine > 0u ? mine : 1u; nx = cnt > 0u ? cnt : 1u;
}

__device__ __forceinline__ void xcd_barrier(const XcdBarrier& b) {
    asm volatile("s_waitcnt vmcnt(0)" ::: "memory");
    __syncthreads();
    if (threadIdx.x == 0) {
        unsigned* bar = b.bar;
        __builtin_amdgcn_s_waitcnt(0);
        unsigned nloc = b.st[0], nx = b.st[1];
        if (nloc == 0u) { xcd_barrier_complete(bar, b.x, nloc, nx); b.st[0] = nloc; b.st[1] = nx; }
        const unsigned old = xb_add(&bar[XB_XSUB(b.x)], 1u);
        const unsigned gen = old / nloc;
        if (old + 1u == (gen + 1u) * nloc) {
            __builtin_amdgcn_fence(__ATOMIC_RELEASE, "agent");
            asm volatile("s_waitcnt vmcnt(0)" ::: "memory");
            const unsigned og = xb_add(&bar[XB_TOP], 1u);
            const unsigned tg = og / nx;
            if (og + 1u == (tg + 1u) * nx) xb_add(&bar[XB_TOPGEN], 1u);
            else XB_SPIN(xb_ld(&bar[XB_TOPGEN]) == tg, bar);
            __builtin_amdgcn_fence(__ATOMIC_ACQUIRE, "agent");
            xb_add(&bar[XB_XGEN(b.x)], 1u);
            asm volatile("s_waitcnt vmcnt(0)" ::: "memory");
        } else {
            XB_SPIN(xb_ld(&bar[XB_XGEN(b.x)]) == gen, bar);
            __builtin_amdgcn_fence(__ATOMIC_ACQUIRE, "agent");
            asm volatile("s_waitcnt vmcnt(0)" ::: "memory");
        }
    }
    __syncthreads();
}


__global__ void __launch_bounds__(256, 2) fwd_megakernel(Params p) {
  extern __shared__ __attribute__((aligned(16))) char smem[];
  cg::grid_group grid = cg::this_grid();
  volatile LAS unsigned* xb_st = (volatile LAS unsigned*)(smem + LDS_MAIN);
  if (threadIdx.x == 0) { xb_st[0] = 0u; xb_st[1] = 0u; xb_st[2] = 0u; xb_st[3] = 0u; }
  __syncthreads();
  XcdBarrier xb = xcd_barrier_post((unsigned*)(p.ws + OFF_BAR), xb_st);
  if (p.lo < 0) grid.sync();
  int pc = 0;
#define PHASE(body)                         \
  {                                         \
    if (pc >= p.lo && pc < p.hi) {          \
      body;                                 \
      if (pc + 1 < p.hi) xcd_barrier(xb);   \
    }                                       \
    pc++;                                   \
  }
  PHASE(phase_prep(p, smem));
#pragma unroll 1
  for (int layer = 0; layer < 4; layer++) {
    const int a = layer >> 1;
    PHASE(phase_prenorm(p, layer));
    if ((layer & 1) == 0) {
      PHASE(phase_attn_inproj(p, layer, a, smem));
      PHASE(phase_attn_up(p, layer, a, smem));
      PHASE(phase_attn_core(p, a, smem));
      PHASE(phase_outproj<1024>(p, layer, (const bf16_t*)(p.ws + OFF_ZS),
                          (const bf16_t*)(p.ws + OFF_WO_A) + (size_t)a * 1024 * 1024, smem));
    } else {
      PHASE(phase_mlp_inproj(p, a, smem));
      PHASE(phase_mlp_spatial(p, a, smem));
      PHASE(phase_outproj<2048>(p, layer, (const bf16_t*)(p.ws + OFF_UZ),
                          (const bf16_t*)(p.ws + OFF_WO_M) + (size_t)a * 1024 * 2048, smem));
    }
  }
  PHASE(phase_final(p));
}

extern "C" void kernel_launch(void* const* d_in, const int* in_sizes, int n_in, void* d_out, int out_size, void* d_ws,
                              size_t ws_size, hipStream_t stream) {
  static int grid_blocks = 0;
  if (!grid_blocks) {
    hipFuncSetAttribute((const void*)fwd_megakernel, hipFuncAttributeMaxDynamicSharedMemorySize, LDS_BYTES);
    int dev = 0, cus = 0, per_cu = 0;
    hipGetDevice(&dev);
    hipDeviceGetAttribute(&cus, hipDeviceAttributeMultiprocessorCount, dev);
    hipOccupancyMaxActiveBlocksPerMultiprocessor(&per_cu, fwd_megakernel, 256, LDS_BYTES);
    if (per_cu > 2) per_cu = 2;
    if (per_cu < 1) per_cu = 1;
    grid_blocks = cus * per_cu;
  }
  Params p{};
  for (int i = 0; i < 22; i++) p.in[i] = (const float*)d_in[i];
  p.out = (float*)d_out;
  p.ws = (char*)d_ws;
  p.lo = 0;
  p.hi = 1000;
  hipMemsetAsync((char*)d_ws + OFF_BAR, 0, 16384 + SZ_MOD, stream);
  void* args[] = {&p};
  hipError_t e = hipLaunchCooperativeKernel((void*)fwd_megakernel, dim3(grid_blocks), dim3(256), args, LDS_BYTES, stream);
  if (e != hipSuccess) fprintf(stderr, "cooperative launch failed: %s (grid %d)\n", hipGetErrorString(e), grid_blocks);
}
```

```cpp
#include <hip/hip_runtime.h>
#include <hip/hip_cooperative_groups.h>
#include <stdint.h>
#include <cstdio>
namespace cg = cooperative_groups;

typedef __attribute__((ext_vector_type(8))) short bf16x8;
typedef __attribute__((ext_vector_type(16))) float f32x16;
typedef unsigned short bf16_t;

#define DEV __device__ __forceinline__

constexpr int D = 1024;
constexpr int T = 12288;
constexpr int TC = 8192;
constexpr int KT = 13312;
constexpr float EPS = 1e-6f;

constexpr size_t SZ_WIN_A = (size_t)2 * 1920 * 1024 * 2;
constexpr size_t SZ_WUQ = (size_t)2 * 1536 * 512 * 2;
constexpr size_t SZ_WUKV = (size_t)2 * 2 * 2048 * 256 * 2;
constexpr size_t SZ_WO_A = (size_t)2 * 1024 * 1024 * 2;
constexpr size_t SZ_WIN_M = (size_t)2 * 6144 * 1024 * 2;
constexpr size_t SZ_WO_M = (size_t)2 * 1024 * 2048 * 2;
constexpr size_t SZ_WS = (size_t)2 * 8 * 128 * 128 * 2;
constexpr size_t SZ_MOD = (size_t)4 * 3 * 3072 * 4;
constexpr size_t SZ_H = (size_t)T * 1024 * 2;
constexpr size_t SZ_CKVK = (size_t)2 * KT * 256 * 2;
constexpr size_t SZ_KPE = (size_t)2 * KT * 64 * 2;
constexpr size_t SZ_STATQ = (size_t)T * 8 * 4;
constexpr size_t SZ_STATKV = (size_t)T * 4 * 4;
constexpr size_t SZ_STATV = (size_t)T * 32 * 2 * 4;

constexpr size_t OFF_WIN_A = 0;
constexpr size_t OFF_WUQ = OFF_WIN_A + SZ_WIN_A;
constexpr size_t OFF_WUKV = OFF_WUQ + SZ_WUQ;
constexpr size_t OFF_WO_A = OFF_WUKV + SZ_WUKV;
constexpr size_t OFF_WIN_M = OFF_WO_A + SZ_WO_A;
constexpr size_t OFF_WO_M = OFF_WIN_M + SZ_WIN_M;
constexpr size_t OFF_WS = OFF_WO_M + SZ_WO_M;
constexpr size_t OFF_MOD = OFF_WS + SZ_WS;
constexpr size_t OFF_H = OFF_MOD + SZ_MOD;
constexpr size_t OFF_CKVK = OFF_H + SZ_H;
constexpr size_t OFF_KPE = OFF_CKVK + SZ_CKVK;
constexpr size_t OFF_STATQ = OFF_KPE + SZ_KPE;
constexpr size_t OFF_STATKV = OFF_STATQ + SZ_STATQ;
constexpr size_t OFF_STATV = OFF_STATKV + SZ_STATKV;
constexpr size_t OFF_UNION = OFF_STATV + SZ_STATV;
constexpr size_t OFF_CQ = OFF_UNION;
constexpr size_t OFF_ZS = OFF_CQ + (size_t)T * 512 * 2;
constexpr size_t OFF_Q = OFF_ZS + (size_t)T * 1024 * 2;
constexpr size_t OFF_KN = OFF_Q + (size_t)T * 1536 * 2;
constexpr size_t OFF_VT = OFF_KN + (size_t)KT * 1024 * 2;
constexpr size_t OFF_UZ = OFF_UNION;
constexpr size_t OFF_GVT = OFF_UZ + (size_t)T * 2048 * 2;

constexpr size_t OFF_BAR = OFF_VT + (size_t)KT * 1024 * 2;
constexpr size_t OFF_MODZ = OFF_BAR + 16384;
constexpr size_t WS_TOTAL = OFF_MODZ + SZ_MOD;

constexpr size_t OUT_CKV = (size_t)T * 1024;
constexpr size_t OUT_KPE = OUT_CKV + (size_t)32 * 2 * 256 * 256;

constexpr int LDS_MAIN = 2 * 2 * 128 * 72 * 2 + 1024;
constexpr int LDS_BYTES = LDS_MAIN + 16;

struct Params {
  const float* in[22];
  float* out;
  char* ws;
  int lo, hi;
};

DEV int opaque_tid() { int t = threadIdx.x; asm volatile("" : "+v"(t)); return t; }
typedef __bf16 hwbf2 __attribute__((ext_vector_type(2)));
typedef float hwf2 __attribute__((ext_vector_type(2)));
DEV unsigned pack2(float a, float b) {
  hwf2 v = {a, b};
  hwbf2 r = __builtin_convertvector(v, hwbf2);
  return *(unsigned*)&r;
}
DEV unsigned short f2bf(float f) { return (unsigned short)(pack2(f, 0.f) & 0xffffu); }
DEV float bf2f(unsigned short b) { return __uint_as_float(((unsigned)b) << 16); }
DEV float bflo(unsigned u) { return __uint_as_float(u << 16); }
DEV float bfhi(unsigned u) { return __uint_as_float(u & 0xffff0000u); }
DEV float silu_f(float x) { return x * __builtin_amdgcn_rcpf(1.f + __expf(-x)); }
DEV float gelu_f(float x) {
  float u = 0.7978845608028654f * (x + 0.044715f * x * x * x);
  return x * __builtin_amdgcn_rcpf(1.f + __expf(-2.f * u));
}
DEV int tok_group(int t) { return t < TC ? 0 : 1 + ((t - TC) >> 11); }
DEV int tok_keyrow(int t) {
  if (t < TC) return t;
  int u = t - TC;
  return TC + (u >> 11) * 2560 + 512 + (u & 2047);
}
DEV float wave_sum(float v) {
  v += __shfl_xor(v, 32);
  v += __shfl_xor(v, 16);
  v += __shfl_xor(v, 8);
  v += __shfl_xor(v, 4);
  v += __shfl_xor(v, 2);
  v += __shfl_xor(v, 1);
  return v;
}
DEV const float* xrow_in(const Params& p, int layer, int t) {
  if (layer == 0) return t < TC ? p.in[0] + (size_t)t * D : p.in[1] + (size_t)(t - TC) * D;
  return p.out + (size_t)t * D;
}

struct NoXf {
  DEV uint4 operator()(uint4 v, int row, int kc) const { return v; }
};

#define GT_LOAD(S, kt_)                                                        \
  {                                                                            \
    const bf16_t* a__ = Ap + (size_t)(kt_) * ksa;                              \
    const bf16_t* w__ = Wp + (size_t)(kt_) * ksw;                              \
    S##a0 = *(const uint4*)(a__);                                              \
    S##a1 = *(const uint4*)(a__ + (size_t)32 * lda);                           \
    S##a2 = *(const uint4*)(a__ + (size_t)64 * lda);                           \
    S##a3 = *(const uint4*)(a__ + (size_t)96 * lda);                           \
    S##w0 = *(const uint4*)(w__);                                              \
    S##w1 = *(const uint4*)(w__ + (size_t)32 * ldw);                           \
    S##w2 = *(const uint4*)(w__ + (size_t)64 * ldw);                           \
    S##w3 = *(const uint4*)(w__ + (size_t)96 * ldw);                           \
  }
#define GT_STORE(S, buf_, kt_)                                              \
  {                                                                         \
    bf16_t* dA = sA + (buf_) * 128 * 72 + lrow * 72 + lkc;                  \
    bf16_t* dW = sW + (buf_) * 128 * 72 + lrow * 72 + lkc;                  \
    *(uint4*)(dA) = S##a0;                                                  \
    *(uint4*)(dA + 32 * 72) = S##a1;                                        \
    *(uint4*)(dA + 64 * 72) = S##a2;                                        \
    *(uint4*)(dA + 96 * 72) = S##a3;                                        \
    *(uint4*)(dW) = xf(S##w0, lrow, (kt_) * 64 + lkc);                      \
    *(uint4*)(dW + 32 * 72) = xf(S##w1, lrow + 32, (kt_) * 64 + lkc);       \
    *(uint4*)(dW + 64 * 72) = xf(S##w2, lrow + 64, (kt_) * 64 + lkc);       \
    *(uint4*)(dW + 96 * 72) = xf(S##w3, lrow + 96, (kt_) * 64 + lkc);       \
  }
#define GT_LDF(dst, p_) dst = *(const bf16x8*)(p_)
#define GT_MMA4(fa0, fa1, fw0, fw1)                                                      \
  acc[0][0] = __builtin_amdgcn_mfma_f32_32x32x16_bf16(fw0, fa0, acc[0][0], 0, 0, 0);     \
  acc[0][1] = __builtin_amdgcn_mfma_f32_32x32x16_bf16(fw1, fa0, acc[0][1], 0, 0, 0);     \
  acc[1][0] = __builtin_amdgcn_mfma_f32_32x32x16_bf16(fw0, fa1, acc[1][0], 0, 0, 0);     \
  acc[1][1] = __builtin_amdgcn_mfma_f32_32x32x16_bf16(fw1, fa1, acc[1][1], 0, 0, 0);
#define GT_COMPUTE(buf_)                                                                   \
  {                                                                                        \
    const bf16_t* cA = sA + (buf_) * 128 * 72 + (wm * 64 + r) * 72 + h * 8;                \
    const bf16_t* cW = sW + (buf_) * 128 * 72 + (wn * 64 + r) * 72 + h * 8;                \
    bf16x8 xa0, xa1, xw0, xw1, ya0, ya1, yw0, yw1;                                         \
    GT_LDF(xa0, cA); GT_LDF(xw0, cW); GT_LDF(xw1, cW + 32 * 72); GT_LDF(xa1, cA + 32 * 72); \
    GT_LDF(ya0, cA + 16); GT_LDF(yw0, cW + 16); GT_LDF(yw1, cW + 32 * 72 + 16); GT_LDF(ya1, cA + 32 * 72 + 16); \
    __builtin_amdgcn_sched_barrier(0);                                                     \
    GT_MMA4(xa0, xa1, xw0, xw1)                                                            \
    __builtin_amdgcn_sched_barrier(0);                                                     \
    GT_LDF(xa0, cA + 32); GT_LDF(xw0, cW + 32); GT_LDF(xw1, cW + 32 * 72 + 32); GT_LDF(xa1, cA + 32 * 72 + 32); \
    __builtin_amdgcn_sched_barrier(0);                                                     \
    GT_MMA4(ya0, ya1, yw0, yw1)                                                            \
    __builtin_amdgcn_sched_barrier(0);                                                     \
    GT_LDF(ya0, cA + 48); GT_LDF(yw0, cW + 48); GT_LDF(yw1, cW + 32 * 72 + 48); GT_LDF(ya1, cA + 32 * 72 + 48); \
    __builtin_amdgcn_sched_barrier(0);                                                     \
    GT_MMA4(xa0, xa1, xw0, xw1)                                                            \
    GT_MMA4(ya0, ya1, yw0, yw1)                                                            \
  }

template <int K, class Epi, class Xf>
DEV void gemm_tile(const bf16_t* __restrict__ A, int lda, const bf16_t* __restrict__ W, int ldw,
                   char* smem, int m0, const Epi& epi, const Xf& xf, size_t ksa = 64, size_t ksw = 64) {
  bf16_t* sA = (bf16_t*)smem;
  bf16_t* sW = sA + 2 * 128 * 72;
  const int tid = opaque_tid(), lane = tid & 63, w = tid >> 6, wm = w & 1, wn = w >> 1;
  const int r = lane & 31, h = lane >> 5;
  f32x16 acc[2][2];
#pragma unroll
  for (int a = 0; a < 2; a++)
#pragma unroll
    for (int b = 0; b < 2; b++)
#pragma unroll
      for (int e = 0; e < 16; e++) acc[a][b][e] = 0.f;
  const int lrow = tid >> 3, lkc = (tid & 7) * 8;
  const bf16_t* Ap = A + (size_t)lrow * lda + lkc;
  const bf16_t* Wp = W + (size_t)lrow * ldw + lkc;
  uint4 Pa0, Pa1, Pa2, Pa3, Pw0, Pw1, Pw2, Pw3;
  uint4 Qa0, Qa1, Qa2, Qa3, Qw0, Qw1, Qw2, Qw3;
  constexpr int nk = K >> 6;
  GT_LOAD(P, 0);
  GT_LOAD(Q, 1);
#pragma unroll 1
  for (int kt = 0; kt < nk; kt += 2) {
    GT_STORE(P, 0, kt);
    __syncthreads();
    GT_LOAD(P, (kt + 2 < nk ? kt + 2 : nk - 2));
    GT_COMPUTE(0);
    GT_STORE(Q, 1, kt + 1);
    __syncthreads();
    GT_LOAD(Q, (kt + 3 < nk ? kt + 3 : nk - 1));
    GT_COMPUTE(1);
  }
  epi(acc[0], m0 + wm * 64 + r, wn, lane);
  epi(acc[1], m0 + wm * 64 + 32 + r, wn, lane);
  __syncthreads();
}

typedef __attribute__((address_space(3))) unsigned lds_u32_t;
#define GG_ISSUE(kt_, buf_)                                                                          \
  {                                                                                                  \
    const bf16_t* a__ = Ag + (size_t)(kt_) * ksa;                                                    \
    const bf16_t* w__ = Wg + (size_t)(kt_) * ksw;                                                    \
    char* d__ = smem + (buf_) * 32768 + w * 1024 + lane * 16;                                        \
    _Pragma("unroll") for (int i_ = 0; i_ < 4; i_++) {                                               \
      __builtin_amdgcn_global_load_lds((const unsigned*)(a__ + (size_t)(32 * i_) * lda),            \
                                       (lds_u32_t*)(d__ + i_ * 4096), 16, 0, 0);                     \
      __builtin_amdgcn_global_load_lds((const unsigned*)(w__ + (size_t)(32 * i_) * ldw),            \
                                       (lds_u32_t*)(d__ + 16384 + i_ * 4096), 16, 0, 0);             \
    }                                                                                                \
  }
#define GG_LDF(dst, base_, kk_) dst = *(const bf16x8*)((base_) + ((((kk_) * 2 + h) ^ fsw) << 4))
#define GG_COMPUTE(buf_)                                                                   \
  {                                                                                        \
    const char* cA = smem + (buf_) * 32768 + (wm * 64 + r) * 128;                          \
    const char* cW = smem + (buf_) * 32768 + 16384 + (wn * 64 + r) * 128;                  \
    bf16x8 xa0, xa1, xw0, xw1, ya0, ya1, yw0, yw1;                                         \
    GG_LDF(xa0, cA, 0); GG_LDF(xw0, cW, 0); GG_LDF(xw1, cW + 4096, 0); GG_LDF(xa1, cA + 4096, 0); \
    GG_LDF(ya0, cA, 1); GG_LDF(yw0, cW, 1); GG_LDF(yw1, cW + 4096, 1); GG_LDF(ya1, cA + 4096, 1); \
    __builtin_amdgcn_sched_barrier(0);                                                     \
    GT_MMA4(xa0, xa1, xw0, xw1)                                                            \
    __builtin_amdgcn_sched_barrier(0);                                                     \
    GG_LDF(xa0, cA, 2); GG_LDF(xw0, cW, 2); GG_LDF(xw1, cW + 4096, 2); GG_LDF(xa1, cA + 4096, 2); \
    __builtin_amdgcn_sched_barrier(0);                                                     \
    GT_MMA4(ya0, ya1, yw0, yw1)                                                            \
    __builtin_amdgcn_sched_barrier(0);                                                     \
    GG_LDF(ya0, cA, 3); GG_LDF(yw0, cW, 3); GG_LDF(yw1, cW + 4096, 3); GG_LDF(ya1, cA + 4096, 3); \
    __builtin_amdgcn_sched_barrier(0);                                                     \
    GT_MMA4(xa0, xa1, xw0, xw1)                                                            \
    GT_MMA4(ya0, ya1, yw0, yw1)                                                            \
  }

template <int K, class Epi>
DEV void gemm_tile_g(const bf16_t* __restrict__ A, int lda, const bf16_t* __restrict__ W, int ldw,
                     char* smem, int m0, const Epi& epi, size_t ksa = 64, size_t ksw = 64) {
  const int tid = opaque_tid(), lane = tid & 63, w = tid >> 6, wm = w & 1, wn = w >> 1;
  const int r = lane & 31, h = lane >> 5;
  const int fsw = (r >> 1) & 7;
  f32x16 acc[2][2];
#pragma unroll
  for (int a = 0; a < 2; a++)
#pragma unroll
    for (int b = 0; b < 2; b++)
#pragma unroll
      for (int e = 0; e < 16; e++) acc[a][b][e] = 0.f;
  const int lrow8 = lane >> 3;
  const int lchunk = (lane & 7) ^ ((((w & 1) << 2) + (lrow8 >> 1)) & 7);
  const bf16_t* Ag = A + (size_t)(w * 8 + lrow8) * lda + lchunk * 8;
  const bf16_t* Wg = W + (size_t)(w * 8 + lrow8) * ldw + lchunk * 8;
  constexpr int nk = K >> 6;
  GG_ISSUE(0, 0);
#pragma unroll 1
  for (int kt = 0; kt < nk; kt += 2) {
    asm volatile("s_waitcnt vmcnt(0)" ::: "memory");
    __syncthreads();
    GG_ISSUE(kt + 1, 1);
    GG_COMPUTE(0);
    asm volatile("s_waitcnt vmcnt(0)" ::: "memory");
    __syncthreads();
    if (kt + 2 < nk) GG_ISSUE(kt + 2, 0);
    GG_COMPUTE(1);
  }
  epi(acc[0], m0 + wm * 64 + r, wn, lane);
  epi(acc[1], m0 + wm * 64 + 32 + r, wn, lane);
  __syncthreads();
}

#define G9_STAGE 20480
#define G9_ISSUE(s_, buf_)                                                                              \
  {                                                                                                     \
    const size_t ko_ = (size_t)((s_) >> 1) * ksa + ((s_) & 1) * 32;                                     \
    const size_t kw_ = (size_t)((s_) >> 1) * ksw + ((s_) & 1) * 32;                                     \
    char* d__ = smem + (buf_) * G9_STAGE + w * 1024 + lane * 16;                                        \
    _Pragma("unroll") for (int i_ = 0; i_ < 3; i_++)                                                    \
      __builtin_amdgcn_global_load_lds((const unsigned*)(Ag + (size_t)(64 * i_) * lda + ko_),          \
                                       (lds_u32_t*)(d__ + i_ * 4096), 16, 0, 0);                        \
    _Pragma("unroll") for (int i_ = 0; i_ < 2; i_++)                                                    \
      __builtin_amdgcn_global_load_lds((const unsigned*)(Wg + (size_t)(64 * i_) * ldw + kw_),          \
                                       (lds_u32_t*)(d__ + 12288 + i_ * 4096), 16, 0, 0);                \
  }

template <int K, class Epi>
DEV void gemm_tile_g192(const bf16_t* __restrict__ A, int lda, const bf16_t* __restrict__ W, int ldw,
                        char* smem, int m0, const Epi& epi, size_t ksa = 64, size_t ksw = 64) {
  const int tid = opaque_tid(), lane = tid & 63, w = tid >> 6, wm = w & 1, wn = w >> 1;
  const int r = lane & 31, h = lane >> 5;
  const int fsw = (r >> 2) & 3;
  f32x16 acc[3][2];
#pragma unroll
  for (int a = 0; a < 3; a++)
#pragma unroll
    for (int b = 0; b < 2; b++)
#pragma unroll
      for (int e = 0; e < 16; e++) acc[a][b][e] = 0.f;
  const int lrow16 = lane >> 2;
  const int lchunk = (lane & 3) ^ ((lane >> 4) & 3);
  const bf16_t* Ag = A + (size_t)(w * 16 + lrow16) * lda + lchunk * 8;
  const bf16_t* Wg = W + (size_t)(w * 16 + lrow16) * ldw + lchunk * 8;
  constexpr int nk = K >> 5;
  asm volatile("s_waitcnt vmcnt(0)" ::: "memory");
  G9_ISSUE(0, 0);
  G9_ISSUE(1, 1);
  int buf = 0;
  const int aoff = (wm * 96 + r) * 64, woff = 12288 + (wn * 64 + r) * 64;
  const int c0 = ((0 + h) ^ fsw) << 4, c1 = ((2 + h) ^ fsw) << 4;
#pragma unroll 1
  for (int s_ = 0; s_ < nk; s_++) {
    if (s_ + 1 < nk) asm volatile("s_waitcnt vmcnt(5)" ::: "memory");
    else asm volatile("s_waitcnt vmcnt(0)" ::: "memory");
    __builtin_amdgcn_s_barrier();
    asm volatile("" ::: "memory");
    if (s_ + 2 < nk) {
      const int nb = buf >= 1 ? buf - 1 : 2;
      G9_ISSUE(s_ + 2, nb);
    }
    const char* cA = smem + buf * G9_STAGE + aoff;
    const char* cW = smem + buf * G9_STAGE + woff;
    {
      bf16x8 a0 = *(const bf16x8*)(cA + c0), a1 = *(const bf16x8*)(cA + 2048 + c0), a2 = *(const bf16x8*)(cA + 4096 + c0);
      bf16x8 w0 = *(const bf16x8*)(cW + c0), w1 = *(const bf16x8*)(cW + 2048 + c0);
      bf16x8 b0 = *(const bf16x8*)(cA + c1), b1 = *(const bf16x8*)(cA + 2048 + c1), b2 = *(const bf16x8*)(cA + 4096 + c1);
      bf16x8 v0 = *(const bf16x8*)(cW + c1), v1 = *(const bf16x8*)(cW + 2048 + c1);
      acc[0][0] = __builtin_amdgcn_mfma_f32_32x32x16_bf16(w0, a0, acc[0][0], 0, 0, 0);
      acc[0][1] = __builtin_amdgcn_mfma_f32_32x32x16_bf16(w1, a0, acc[0][1], 0, 0, 0);
      acc[1][0] = __builtin_amdgcn_mfma_f32_32x32x16_bf16(w0, a1, acc[1][0], 0, 0, 0);
      acc[1][1] = __builtin_amdgcn_mfma_f32_32x32x16_bf16(w1, a1, acc[1][1], 0, 0, 0);
      acc[2][0] = __builtin_amdgcn_mfma_f32_32x32x16_bf16(w0, a2, acc[2][0], 0, 0, 0);
      acc[2][1] = __builtin_amdgcn_mfma_f32_32x32x16_bf16(w1, a2, acc[2][1], 0, 0, 0);
      acc[0][0] = __builtin_amdgcn_mfma_f32_32x32x16_bf16(v0, b0, acc[0][0], 0, 0, 0);
      acc[0][1] = __builtin_amdgcn_mfma_f32_32x32x16_bf16(v1, b0, acc[0][1], 0, 0, 0);
      acc[1][0] = __builtin_amdgcn_mfma_f32_32x32x16_bf16(v0, b1, acc[1][0], 0, 0, 0);
      acc[1][1] = __builtin_amdgcn_mfma_f32_32x32x16_bf16(v1, b1, acc[1][1], 0, 0, 0);
      acc[2][0] = __builtin_amdgcn_mfma_f32_32x32x16_bf16(v0, b2, acc[2][0], 0, 0, 0);
      acc[2][1] = __builtin_amdgcn_mfma_f32_32x32x16_bf16(v1, b2, acc[2][1], 0, 0, 0);
    }
    buf = buf == 2 ? 0 : buf + 1;
  }
#pragma unroll
  for (int ti = 0; ti < 3; ti++) epi(acc[ti], m0 + wm * 96 + ti * 32 + r, wn, lane);
  __syncthreads();
}

DEV void rope_pair(f32x16& a, int pos, int h) {
#pragma unroll
  for (int j = 0; j < 2; j++)
#pragma unroll
    for (int i = 0; i < 4; i++) {
      int f = h * 4 + 8 * j + i;
      float inv = __builtin_amdgcn_exp2f(-(float)f * 0.8304820237218406f);
      float ang = (float)pos * inv;
      float sn, cs;
      __sincosf(ang, &sn, &cs);
      float x1 = a[4 * j + i], x2 = a[4 * (j + 2) + i];
      a[4 * j + i] = x1 * cs - x2 * sn;
      a[4 * (j + 2) + i] = x1 * sn + x2 * cs;
    }
}

DEV int perm_src(int mode, int np) {
  if (mode == 0) {
    if (np < 768) return np;
    if (np < 1792) return np + 64;
    if (np < 1856) return np - 1024;
    return -1;
  } else if (mode == 1) {
    if (np < 4096) {
      int c = np >> 6, rr = np & 63;
      return rr < 32 ? 32 * c + rr : 4096 + 32 * c + (rr - 32);
    }
    return 2048 + (np - 4096);
  }
  return np;
}

DEV void transpose_tile(const float* __restrict__ src, int N, bf16_t* __restrict__ dst, int K, int np0, int k0,
                        int mode, const float* __restrict__ kscale, float* tile, int tm_rows = 0) {
  const int tid = opaque_tid();
  const int tx = tid & 63, ty = tid >> 6;
  const int ns = perm_src(mode, np0 + tx);
  const float vmask = ns >= 0 ? 1.f : 0.f;
  const float* sp = src + (size_t)(k0 + ty) * N + (ns >= 0 ? ns : 0);
  float tv[16];
#pragma unroll
  for (int i = 0; i < 16; i++) tv[i] = sp[(size_t)(4 * i) * N];
  if (kscale) {
    float ks[16];
#pragma unroll
    for (int i = 0; i < 16; i++) ks[i] = kscale[k0 + ty + 4 * i];
#pragma unroll
    for (int i = 0; i < 16; i++) tv[i] *= ks[i];
  }
#pragma unroll
  for (int i = 0; i < 16; i++) tile[(ty + 4 * i) * 65 + tx] = tv[i] * vmask;
  __syncthreads();
  const int rr = tid >> 2, seg = tid & 3;
  unsigned o[8];
#pragma unroll
  for (int e = 0; e < 8; e++) {
    float a = tile[(seg * 16 + 2 * e) * 65 + rr];
    float b = tile[(seg * 16 + 2 * e + 1) * 65 + rr];
    o[e] = pack2(a, b);
  }
  uint4* dp = tm_rows ? (uint4*)(dst + ((size_t)(k0 >> 6) * tm_rows + np0 + rr) * 64 + seg * 16)
                      : (uint4*)(dst + (size_t)(np0 + rr) * K + k0 + seg * 16);
  dp[0] = make_uint4(o[0], o[1], o[2], o[3]);
  dp[1] = make_uint4(o[4], o[5], o[6], o[7]);
  __syncthreads();
}

DEV void transpose_item(const Params& p, int t, float* fl) {
  if (t < 960) {
    int l = t / 480, q = t % 480, nt = q / 16, kt = q % 16;
    transpose_tile(p.in[9] + (size_t)l * 1024 * 1856, 1856, (bf16_t*)(p.ws + OFF_WIN_A) + (size_t)l * 1920 * 1024,
                   1024, nt * 64, kt * 64, 0, nullptr, fl, 1920);
  } else if (t < 960 + 384) {
    t -= 960;
    int l = t / 192, q = t % 192, nt = q / 8, kt = q % 8;
    transpose_tile(p.in[12] + (size_t)l * 512 * 1536, 1536, (bf16_t*)(p.ws + OFF_WUQ) + (size_t)l * 1536 * 512, 512,
                   nt * 64, kt * 64, 2, p.in[10] + l * 512, fl);
  } else if (t < 960 + 384 + 512) {
    t -= 960 + 384;
    int lv = t / 128, q = t % 128, nt = q / 4, kt = q % 4;
    int l = lv >> 1, ver = lv & 1;
    transpose_tile(p.in[13] + (size_t)l * 256 * 2048, 2048, (bf16_t*)(p.ws + OFF_WUKV) + (size_t)lv * 2048 * 256, 256,
                   nt * 64, kt * 64, 2, ver == 0 ? p.in[11] + l * 256 : nullptr, fl);
  } else if (t < 960 + 384 + 512 + 512) {
    t -= 960 + 384 + 512;
    int l = t / 256, q = t % 256, nt = q / 16, kt = q % 16;
    transpose_tile(p.in[14] + (size_t)l * 1024 * 1024, 1024, (bf16_t*)(p.ws + OFF_WO_A) + (size_t)l * 1024 * 1024,
                   1024, nt * 64, kt * 64, 2, nullptr, fl);
  } else if (t < 960 + 384 + 512 + 512 + 3072) {
    t -= 960 + 384 + 512 + 512;
    int l = t / 1536, q = t % 1536, nt = q / 16, kt = q % 16;
    transpose_tile(p.in[15] + (size_t)l * 1024 * 6144, 6144, (bf16_t*)(p.ws + OFF_WIN_M) + (size_t)l * 6144 * 1024,
                   1024, nt * 64, kt * 64, 1, nullptr, fl, 6144);
  } else {
    t -= 960 + 384 + 512 + 512 + 3072;
    int l = t / 512, q = t % 512, nt = q / 32, kt = q % 32;
    transpose_tile(p.in[20] + (size_t)l * 2048 * 1024, 1024, (bf16_t*)(p.ws + OFF_WO_M) + (size_t)l * 1024 * 2048,
                   2048, nt * 64, kt * 64, 2, nullptr, fl);
  }
}

DEV void phase_prep(const Params& p, char* smem) {
  float* fl = (float*)smem;
  const int tid = opaque_tid(), lane = tid & 63, w = tid >> 6;
  constexpr int N_MOD = 384, N_TR = 1184, N_WS = 128, N_CKV = 256, N_KPE = 64;
  constexpr int N_ALL = N_MOD + N_TR + N_WS + N_CKV + N_KPE;
  for (int it = blockIdx.x; it < N_ALL; it += gridDim.x) {
    if (it < N_MOD) {
      const int l = it / 96, ch = (it % 96) >> 2, kq = it & 3;
      float* sc = fl;
      float* red = fl + 3072;
      for (int i = tid; i < 3072; i += 256) {
        int g = i >> 10, k = i & 1023;
        float cv = g == 0 ? p.in[5][k] : p.in[4][(g - 1) * 1024 + k];
        sc[i] = silu_f(cv);
      }
      __syncthreads();
      const float* wm_ = p.in[7] + (size_t)l * 1024 * 3072 + ch * 128 + lane * 2;
      float a0[3] = {0.f, 0.f, 0.f}, a1[3] = {0.f, 0.f, 0.f};
#pragma unroll 16
      for (int k = kq * 256 + w * 64; k < kq * 256 + w * 64 + 64; k++) {
        float2 wv = *(const float2*)(wm_ + (size_t)k * 3072);
#pragma unroll
        for (int g = 0; g < 3; g++) {
          float s = sc[g * 1024 + k];
          a0[g] += s * wv.x;
          a1[g] += s * wv.y;
        }
      }
#pragma unroll
      for (int g = 0; g < 3; g++) {
        red[(w * 3 + g) * 128 + lane * 2] = a0[g];
        red[(w * 3 + g) * 128 + lane * 2 + 1] = a1[g];
      }
      __syncthreads();
      for (int i = tid; i < 384; i += 256) {
        int g = i >> 7, c = i & 127;
        float s = red[(0 * 3 + g) * 128 + c] + red[(1 * 3 + g) * 128 + c] + red[(2 * 3 + g) * 128 + c] +
                  red[(3 * 3 + g) * 128 + c];
        int n = ch * 128 + c;
        atomicAdd(&((float*)(p.ws + OFF_MODZ))[(l * 3 + g) * 3072 + n], s + (kq == 0 ? p.in[8][l * 3072 + n] : 0.f));
      }
      __syncthreads();
    } else if (it < N_MOD + N_TR) {
      const int i = it - N_MOD;
      const int t = i < 480 ? i : i < 672 ? 960 + (i - 480) : i < 928 ? 1344 + (i - 672) : 1856 + (i - 928);
      transpose_item(p, t, fl);
    } else {
      int t = it - N_MOD - N_TR;
      const float* src;
      bf16_t* dst;
      if (t < N_WS) {
        size_t e = (size_t)t * 2048 + tid * 8;
        src = p.in[18] + e;
        dst = (bf16_t*)(p.ws + OFF_WS) + e;
      } else if (t < N_WS + N_CKV) {
        t -= N_WS;
        size_t e = (size_t)t * 2048 + tid * 8;
        int col = e & 255;
        int rowi = (int)(e >> 8);
        int pp = rowi & 511, la = rowi >> 9, a = la & 1, lb = la >> 1;
        src = p.in[2] + e;
        dst = (bf16_t*)(p.ws + OFF_CKVK) + ((size_t)a * KT + TC + lb * 2560 + pp) * 256 + col;
      } else {
        t -= N_WS + N_CKV;
        size_t e = (size_t)t * 2048 + tid * 8;
        int col = e & 63;
        int rowi = (int)(e >> 6);
        int pp = rowi & 511, la = rowi >> 9, a = la & 1, lb = la >> 1;
        src = p.in[3] + e;
        dst = (bf16_t*)(p.ws + OFF_KPE) + ((size_t)a * KT + TC + lb * 2560 + pp) * 64 + col;
      }
      float4 v0 = *(const float4*)src, v1 = *(const float4*)(src + 4);
      *(uint4*)dst = make_uint4(pack2(v0.x, v0.y), pack2(v0.z, v0.w), pack2(v1.x, v1.y), pack2(v1.z, v1.w));
    }
  }
}

DEV void phase_prenorm(const Params& p, int layer) {
  const int tid_ = opaque_tid(); const int lane = tid_ & 63, w = tid_ >> 6;
  bf16_t* H = (bf16_t*)(p.ws + OFF_H);
  const float* mod = (const float*)(p.ws + OFF_MODZ);
  const float* ng = p.in[6] + layer * 1024;
  for (int row = blockIdx.x * 4 + w; row < T; row += gridDim.x * 4) {
    const float* xr = xrow_in(p, layer, row);
    float4 v[4];
    float ss = 0.f;
#pragma unroll
    for (int i = 0; i < 4; i++) {
      v[i] = *(const float4*)(xr + i * 256 + lane * 4);
      ss += v[i].x * v[i].x + v[i].y * v[i].y + v[i].z * v[i].z + v[i].w * v[i].w;
    }
    ss = wave_sum(ss);
    const float rstd = rsqrtf(ss * (1.f / 1024.f) + EPS);
    const float* sh = mod + (layer * 3 + tok_group(row)) * 3072;
    const float* sc = sh + 1024;
#pragma unroll
    for (int i = 0; i < 4; i++) {
      int c = i * 256 + lane * 4;
      float4 g = *(const float4*)(ng + c), s = *(const float4*)(sc + c), b = *(const float4*)(sh + c);
      float o0 = v[i].x * rstd * g.x * (1.f + s.x) + b.x;
      float o1 = v[i].y * rstd * g.y * (1.f + s.y) + b.y;
      float o2 = v[i].z * rstd * g.z * (1.f + s.z) + b.z;
      float o3 = v[i].w * rstd * g.w * (1.f + s.w) + b.w;
      *(uint2*)(H + ((size_t)(c >> 6) * T + row) * 64 + (c & 63)) = make_uint2(pack2(o0, o1), pack2(o2, o3));
    }
  }
}

DEV void phase_attn_inproj(const Params& p, int layer, int a, char* smem) {
  const bf16_t* H = (const bf16_t*)(p.ws + OFF_H);
  const bf16_t* W = (const bf16_t*)(p.ws + OFF_WIN_A) + (size_t)a * 1920 * 1024;
  bf16_t* CQ = (bf16_t*)(p.ws + OFF_CQ);
  bf16_t* ZS = (bf16_t*)(p.ws + OFF_ZS);
  bf16_t* CKVK = (bf16_t*)(p.ws + OFF_CKVK) + (size_t)a * KT * 256;
  bf16_t* KPE = (bf16_t*)(p.ws + OFF_KPE) + (size_t)a * KT * 64;
  float* statq = (float*)(p.ws + OFF_STATQ);
  float* statkv = (float*)(p.ws + OFF_STATKV);
  float* out_kpe = p.out + OUT_KPE;
  for (int j_ = blockIdx.x >> 3; j_ < 12 * 15; j_ += gridDim.x >> 3) {
    const int mt = (blockIdx.x & 7) * 12 + j_ % 12, nt = j_ / 12;
    const int m0 = mt * 128, n0 = nt * 128;
    auto epi = [=](f32x16(&acc)[2], int token, int wn, int lane) {
      const int r = lane & 31, h = lane >> 5;
      {
        if (nt < 6) {
          float ss = 0.f;
          bf16_t* dst = nt < 4 ? CQ + (size_t)token * 512 + n0 + wn * 64
                               : CKVK + (size_t)tok_keyrow(token) * 256 + (n0 - 512) + wn * 64;
#pragma unroll
          for (int fi = 0; fi < 2; fi++)
#pragma unroll
            for (int j = 0; j < 4; j++) {
              float v0 = acc[fi][4 * j], v1 = acc[fi][4 * j + 1], v2 = acc[fi][4 * j + 2],
                    v3 = acc[fi][4 * j + 3];
              ss += v0 * v0 + v1 * v1 + v2 * v2 + v3 * v3;
              *(uint2*)(dst + fi * 32 + h * 4 + 8 * j) = make_uint2(pack2(v0, v1), pack2(v2, v3));
            }
          ss += __shfl_xor(ss, 32);
          if (h == 0) {
            if (nt < 4) statq[token * 8 + nt * 2 + wn] = ss;
            else statkv[token * 4 + (nt - 4) * 2 + wn] = ss;
          }
        } else if (nt < 14) {
          bf16_t* dst = ZS + (size_t)token * 1024 + (n0 - 768) + wn * 64;
#pragma unroll
          for (int fi = 0; fi < 2; fi++)
#pragma unroll
            for (int j = 0; j < 4; j++) {
              float v0 = silu_f(acc[fi][4 * j]), v1 = silu_f(acc[fi][4 * j + 1]),
                    v2 = silu_f(acc[fi][4 * j + 2]), v3 = silu_f(acc[fi][4 * j + 3]);
              *(uint2*)(dst + fi * 32 + h * 4 + 8 * j) = make_uint2(pack2(v0, v1), pack2(v2, v3));
            }
        } else if (wn == 0) {
          if (token < TC) {
            float* od = out_kpe + ((size_t)((token >> 8) * 2 + a) * 256 + (token & 255)) * 64;
#pragma unroll
            for (int fi = 0; fi < 2; fi++)
#pragma unroll
              for (int j = 0; j < 4; j++)
                *(float4*)(od + fi * 32 + h * 4 + 8 * j) =
                    make_float4(acc[fi][4 * j], acc[fi][4 * j + 1], acc[fi][4 * j + 2], acc[fi][4 * j + 3]);
          } else {
            int s = (token - TC) & 2047;
            rope_pair(acc[0], s >> 6, h);
            rope_pair(acc[1], s & 63, h);
          }
          bf16_t* dst = KPE + (size_t)tok_keyrow(token) * 64;
#pragma unroll
          for (int fi = 0; fi < 2; fi++)
#pragma unroll
            for (int j = 0; j < 4; j++)
              *(uint2*)(dst + fi * 32 + h * 4 + 8 * j) =
                  make_uint2(pack2(acc[fi][4 * j], acc[fi][4 * j + 1]), pack2(acc[fi][4 * j + 2], acc[fi][4 * j + 3]));
        }
      }
    };
    gemm_tile_g<1024>(H + (size_t)m0 * 64, 64, W + (size_t)n0 * 64, 64, smem, m0, epi, (size_t)T * 64, (size_t)1920 * 64);
  }
}

DEV void phase_attn_up(const Params& p, int layer, int a, char* smem) {
  const bf16_t* CQ = (const bf16_t*)(p.ws + OFF_CQ);
  const bf16_t* WUQ = (const bf16_t*)(p.ws + OFF_WUQ) + (size_t)a * 1536 * 512;
  const bf16_t* CKVK = (const bf16_t*)(p.ws + OFF_CKVK) + (size_t)a * KT * 256;
  bf16_t* Q = (bf16_t*)(p.ws + OFF_Q);
  bf16_t* KN = (bf16_t*)(p.ws + OFF_KN);
  bf16_t* VT = (bf16_t*)(p.ws + OFF_VT);
  const float* statq = (const float*)(p.ws + OFF_STATQ);
  const float* statkv = (const float*)(p.ws + OFF_STATKV);
  constexpr int NQ = 96 * 12, NKV = 104 * 16, NCK = 128;
  const float qscale = 0.07216878364870322f * 1.4426950408889634f;
  const int xcd_ = blockIdx.x & 7;
  for (int t = blockIdx.x >> 3; t < (NQ + NKV + NCK) / 8; t += gridDim.x >> 3) {
    if (t < NQ / 8) {
      const int mt = xcd_ * 12 + t % 12, nt = t / 12;
      const int m0 = mt * 128, n0 = nt * 128;
      auto epi = [=](f32x16(&acc)[2], int token, int wn, int lane) {
        const int r = lane & 31, h = lane >> 5;
        const int b64 = (n0 + wn * 64) >> 6;
        const bool ropeblk = (b64 % 3) == 2;
        {
          const float4 s0 = *(const float4*)(statq + token * 8), s1 = *(const float4*)(statq + token * 8 + 4);
          const float ss = s0.x + s0.y + s0.z + s0.w + s1.x + s1.y + s1.z + s1.w;
          const float sc = rsqrtf(ss * (1.f / 512.f) + EPS) * qscale;
#pragma unroll
          for (int fi = 0; fi < 2; fi++)
#pragma unroll
            for (int e = 0; e < 16; e++) acc[fi][e] *= sc;
          if (ropeblk && token >= TC) {
            int s = (token - TC) & 2047;
            rope_pair(acc[0], s >> 6, h);
            rope_pair(acc[1], s & 63, h);
          }
          bf16_t* dst = Q + (size_t)token * 1536 + n0 + wn * 64;
#pragma unroll
          for (int fi = 0; fi < 2; fi++)
#pragma unroll
            for (int j = 0; j < 4; j++)
              *(uint2*)(dst + fi * 32 + h * 4 + 8 * j) =
                  make_uint2(pack2(acc[fi][4 * j], acc[fi][4 * j + 1]), pack2(acc[fi][4 * j + 2], acc[fi][4 * j + 3]));
        }
      };
      gemm_tile_g<512>(CQ + (size_t)m0 * 512, 512, WUQ + (size_t)n0 * 512, 512, smem, m0, epi);
    } else if (t < (NQ + NKV) / 8) {
      const int tt = t - NQ / 8;
      const int mt = xcd_ * 13 + tt % 13, nt = tt / 13;
      const int m0 = mt * 128, n0 = nt * 128;
      const bool isCache = (m0 >= TC) && (((m0 - TC) % 2560) < 512);
      const bf16_t* WUKV = (const bf16_t*)(p.ws + OFF_WUKV) + (size_t)(a * 2 + (isCache ? 1 : 0)) * 2048 * 256;
      const int head = nt >> 1;
      auto epi = [=](f32x16(&acc)[2], int token, int wn, int lane) {
        const int r = lane & 31, h = lane >> 5;
        {
          const int krow = token;
          float sc = 1.f;
          if (!isCache) {
            int token = krow;
            if (krow >= TC) {
              int u = krow - TC;
              int lb = u / 2560;
              token = TC + lb * 2048 + (u - lb * 2560 - 512);
            }
            const float4 s0 = *(const float4*)(statkv + token * 4);
            sc = rsqrtf((s0.x + s0.y + s0.z + s0.w) * (1.f / 256.f) + EPS);
          }
          if ((nt & 1) == 0) {
            bf16_t* dst = KN + (size_t)krow * 1024 + head * 128 + wn * 64;
#pragma unroll
            for (int fi = 0; fi < 2; fi++)
#pragma unroll
              for (int j = 0; j < 4; j++)
                *(uint2*)(dst + fi * 32 + h * 4 + 8 * j) =
                    make_uint2(pack2(acc[fi][4 * j] * sc, acc[fi][4 * j + 1] * sc),
                               pack2(acc[fi][4 * j + 2] * sc, acc[fi][4 * j + 3] * sc));
          } else {
            bf16_t* dst = VT + (size_t)(head * 128 + wn * 64) * KT + krow;
#pragma unroll
            for (int fi = 0; fi < 2; fi++)
#pragma unroll
              for (int e = 0; e < 16; e++) {
                int dv = fi * 32 + h * 4 + 8 * (e >> 2) + (e & 3);
                dst[(size_t)dv * KT] = f2bf(acc[fi][e] * sc);
              }
          }
        }
      };
      gemm_tile_g<256>(CKVK + (size_t)m0 * 256, 256, WUKV + (size_t)n0 * 256, 256, smem, m0, epi);
    } else {
      const int tt = xcd_ * 16 + (t - (NQ + NKV) / 8);
      const float* gk = p.in[11] + a * 256;
      float* oc = p.out + OUT_CKV;
      for (int i = threadIdx.x; i < 64 * 32; i += 256) {
        int token = tt * 64 + (i >> 5), c = (i & 31) * 8;
        const float4 s0 = *(const float4*)(statkv + token * 4);
        const float sc = rsqrtf((s0.x + s0.y + s0.z + s0.w) * (1.f / 256.f) + EPS);
        uint4 v = *(const uint4*)(CKVK + (size_t)token * 256 + c);
        float4 g0 = *(const float4*)(gk + c), g1 = *(const float4*)(gk + c + 4);
        float* od = oc + ((size_t)((token >> 8) * 2 + a) * 256 + (token & 255)) * 256 + c;
        *(float4*)od = make_float4(bflo(v.x) * sc * g0.x, bfhi(v.x) * sc * g0.y, bflo(v.y) * sc * g0.z, bfhi(v.y) * sc * g0.w);
        *(float4*)(od + 4) = make_float4(bflo(v.z) * sc * g1.x, bfhi(v.z) * sc * g1.y, bflo(v.w) * sc * g1.z, bfhi(v.w) * sc * g1.w);
      }
    }
  }
}

DEV void phase_attn_core(const Params& p, int a, char* smem) {
  const bf16_t* Q = (const bf16_t*)(p.ws + OFF_Q);
  const bf16_t* KN = (const bf16_t*)(p.ws + OFF_KN);
  const bf16_t* VT = (const bf16_t*)(p.ws + OFF_VT);
  const bf16_t* KPE = (const bf16_t*)(p.ws + OFF_KPE) + (size_t)a * KT * 64;
  bf16_t* ZS = (bf16_t*)(p.ws + OFF_ZS);
  bf16_t* sK = (bf16_t*)smem;
  bf16_t* sV = sK + 64 * 200;
  const int tid = opaque_tid(), lane = tid & 63, w = tid >> 6, r = lane & 31, h = lane >> 5;
  const int qh = w;
  const int xcd = blockIdx.x & 7, nloc = gridDim.x >> 3, local = blockIdx.x >> 3, nheavy = nloc >> 1;
  const bool heavyblk = local < nheavy;
  const int istart = heavyblk ? local : local - nheavy;
  const int istep = heavyblk ? nheavy : nloc - nheavy;
  const int iend = heavyblk ? 32 : 64;
  for (int item = istart; item < iend; item += istep) {
    int head, tq0, kr0, nkt;
    if (heavyblk) {
      int pair = xcd * 2 + (item >> 4);
      int lb = pair >> 3;
      head = pair & 7;
      tq0 = TC + lb * 2048 + (item & 15) * 128;
      kr0 = TC + lb * 2560;
      nkt = 40;
    } else {
      int pair = xcd * 32 + (item >> 1);
      int b = pair >> 3;
      head = pair & 7;
      tq0 = b * 256 + (item & 1) * 128;
      kr0 = b * 256;
      nkt = 4;
    }
    bf16x8 qf[12];
    {
      const bf16_t* qp = Q + (size_t)(tq0 + qh * 32 + r) * 1536 + head * 192 + h * 8;
#pragma unroll
      for (int kk = 0; kk < 12; kk++) qf[kk] = *(const bf16x8*)(qp + kk * 16);
    }
    f32x16 o[4];
#pragma unroll
    for (int d = 0; d < 4; d++)
#pragma unroll
      for (int e = 0; e < 16; e++) o[d][e] = 0.f;
    float m = -1e30f, l = 0.f;
    uint4 rk0, rk1, rk2, rv0, rv1;
    const int krow_ = tid >> 3, kpart = tid & 7, vrow = tid >> 1, vhalf = tid & 1;
    const bf16_t* kn_p = KN + (size_t)(kr0 + krow_) * 1024 + head * 128 + kpart * 16;
    const bf16_t* kpe_p = KPE + (size_t)(kr0 + krow_) * 64 + kpart * 8;
    const bf16_t* vt_p = VT + (size_t)(head * 128 + vrow) * KT + kr0 + vhalf * 16;
    bf16_t* sKb = (bf16_t*)smem;
    bf16_t* sVb = sKb + 2 * 32 * 200;
#define AGLOAD(t_)                                                      \
  {                                                                     \
    const bf16_t* a_ = kn_p + (size_t)(t_) * 32 * 1024;                 \
    rk0 = *(const uint4*)(a_);                                          \
    rk1 = *(const uint4*)(a_ + 8);                                      \
    rk2 = *(const uint4*)(kpe_p + (size_t)(t_) * 32 * 64);              \
    const bf16_t* c_ = vt_p + (t_) * 32;                                \
    rv0 = *(const uint4*)(c_);                                          \
    rv1 = *(const uint4*)(c_ + 8);                                      \
  }
#define ASTORE(buf_)                                                    \
  {                                                                     \
    bf16_t* d_ = sKb + (buf_) * 32 * 200 + krow_ * 200;                 \
    *(uint4*)(d_ + kpart * 16) = rk0;                                   \
    *(uint4*)(d_ + kpart * 16 + 8) = rk1;                               \
    *(uint4*)(d_ + 128 + kpart * 8) = rk2;                              \
    bf16_t* f_ = sVb + (buf_) * 128 * 40 + vrow * 40 + vhalf * 16;      \
    *(uint4*)(f_) = rv0;                                                \
    *(uint4*)(f_ + 8) = rv1;                                            \
  }
    const int nt32 = nkt * 2;
    AGLOAD(0);
    ASTORE(0);
    AGLOAD(1);
    for (int t = 0; t < nt32; t++) {
      __syncthreads();
      if (t + 1 < nt32) {
        ASTORE((t + 1) & 1);
        if (t + 2 < nt32) AGLOAD(t + 2);
      }
      const bf16_t* sK = sKb + (t & 1) * 32 * 200;
      const bf16_t* sV = sVb + (t & 1) * 128 * 40;
      f32x16 sv;
#pragma unroll
      for (int e = 0; e < 16; e++) sv[e] = 0.f;
#define ALDV(d_, s2_) ({ union { bf16x8 v; uint2 u[2]; } t_; const bf16_t* vp_ = vbase + (d_) * 1280 + 16 * (s2_); \
                         t_.u[0] = *(const uint2*)vp_; t_.u[1] = *(const uint2*)(vp_ + 8); t_.v; })
      const bf16_t* kp = sK + r * 200 + h * 8;
      const bf16_t* vbase = sV + r * 40 + 4 * h;
      bf16x8 kq0 = *(const bf16x8*)(kp), kq1 = *(const bf16x8*)(kp + 16), kq2 = *(const bf16x8*)(kp + 32),
             kq3 = *(const bf16x8*)(kp + 48);
#pragma unroll
      for (int kk = 0; kk < 12; kk += 4) {
        __builtin_amdgcn_sched_barrier(0);
        sv = __builtin_amdgcn_mfma_f32_32x32x16_bf16(kq0, qf[kk], sv, 0, 0, 0);
        if (kk + 4 < 12) kq0 = *(const bf16x8*)(kp + (kk + 4) * 16);
        __builtin_amdgcn_sched_barrier(0);
        sv = __builtin_amdgcn_mfma_f32_32x32x16_bf16(kq1, qf[kk + 1], sv, 0, 0, 0);
        if (kk + 4 < 12) kq1 = *(const bf16x8*)(kp + (kk + 5) * 16);
        __builtin_amdgcn_sched_barrier(0);
        sv = __builtin_amdgcn_mfma_f32_32x32x16_bf16(kq2, qf[kk + 2], sv, 0, 0, 0);
        if (kk + 4 < 12) kq2 = *(const bf16x8*)(kp + (kk + 6) * 16);
        __builtin_amdgcn_sched_barrier(0);
        sv = __builtin_amdgcn_mfma_f32_32x32x16_bf16(kq3, qf[kk + 3], sv, 0, 0, 0);
        if (kk + 4 < 12) kq3 = *(const bf16x8*)(kp + (kk + 7) * 16);
      }
      __builtin_amdgcn_sched_barrier(0);
      bf16x8 va = ALDV(0, 0), vb = ALDV(1, 0), vc = ALDV(2, 0), vd = ALDV(3, 0);
      __builtin_amdgcn_sched_barrier(0);
      float mx = sv[0];
#pragma unroll
      for (int e = 1; e < 16; e++) mx = fmaxf(mx, sv[e]);
      mx = fmaxf(mx, __shfl_xor(mx, 32));
      const float mnew = fmaxf(m, mx);
      const float alpha = __builtin_amdgcn_exp2f(m - mnew);
      m = mnew;
      float ps = 0.f;
#pragma unroll
      for (int e = 0; e < 16; e++) {
        float pv = __builtin_amdgcn_exp2f(sv[e] - mnew);
        sv[e] = pv;
        ps += pv;
      }
      l = l * alpha + ps;
      if (!__all(alpha == 1.f)) {
#pragma unroll
        for (int d = 0; d < 4; d++)
#pragma unroll
          for (int e = 0; e < 16; e++) o[d][e] *= alpha;
      }
      union { bf16x8 v; unsigned u[4]; } pf0, pf1;
#pragma unroll
      for (int e = 0; e < 4; e++) {
        pf0.u[e] = pack2(sv[2 * e], sv[2 * e + 1]);
        pf1.u[e] = pack2(sv[8 + 2 * e], sv[8 + 2 * e + 1]);
      }
      __builtin_amdgcn_sched_barrier(0);
      o[0] = __builtin_amdgcn_mfma_f32_32x32x16_bf16(va, pf0.v, o[0], 0, 0, 0);
      va = ALDV(0, 1);
      __builtin_amdgcn_sched_barrier(0);
      o[1] = __builtin_amdgcn_mfma_f32_32x32x16_bf16(vb, pf0.v, o[1], 0, 0, 0);
      vb = ALDV(1, 1);
      __builtin_amdgcn_sched_barrier(0);
      o[2] = __builtin_amdgcn_mfma_f32_32x32x16_bf16(vc, pf0.v, o[2], 0, 0, 0);
      vc = ALDV(2, 1);
      __builtin_amdgcn_sched_barrier(0);
      o[3] = __builtin_amdgcn_mfma_f32_32x32x16_bf16(vd, pf0.v, o[3], 0, 0, 0);
      vd = ALDV(3, 1);
      __builtin_amdgcn_sched_barrier(0);
      o[0] = __builtin_amdgcn_mfma_f32_32x32x16_bf16(va, pf1.v, o[0], 0, 0, 0);
      o[1] = __builtin_amdgcn_mfma_f32_32x32x16_bf16(vb, pf1.v, o[1], 0, 0, 0);
      o[2] = __builtin_amdgcn_mfma_f32_32x32x16_bf16(vc, pf1.v, o[2], 0, 0, 0);
      o[3] = __builtin_amdgcn_mfma_f32_32x32x16_bf16(vd, pf1.v, o[3], 0, 0, 0);
    }
    __syncthreads();
    {
    l += __shfl_xor(l, 32);
    const float inv = 1.f / l;
    bf16_t* zp = ZS + (size_t)(tq0 + qh * 32 + r) * 1024 + head * 128;
#pragma unroll
    for (int d = 0; d < 4; d++)
#pragma unroll
      for (int j = 0; j < 4; j++) {
        bf16_t* ap = zp + d * 32 + h * 4 + 8 * j;
        uint2 z = *(const uint2*)ap;
        float v0 = o[d][4 * j] * inv * bflo(z.x), v1 = o[d][4 * j + 1] * inv * bfhi(z.x);
        float v2 = o[d][4 * j + 2] * inv * bflo(z.y), v3 = o[d][4 * j + 3] * inv * bfhi(z.y);
        *(uint2*)ap = make_uint2(pack2(v0, v1), pack2(v2, v3));
      }
    }
  }
  if (a == 0 && !heavyblk) {
    __syncthreads();
    const int nlight = 8 * (nloc - nheavy), rank = xcd + 8 * (local - nheavy);
    for (int i = rank; i < 5280; i += nlight) {
      const int t = i < 480 ? 480 + i : i < 672 ? 1152 + (i - 480) : i < 928 ? 1600 + (i - 672)
                                    : i < 1184 ? 2112 + (i - 928) : 2368 + (i - 1184);
      transpose_item(p, t, (float*)smem);
    }
  }
}

template <int K>
DEV void phase_outproj(const Params& p, int layer, const bf16_t* A, const bf16_t* W, char* smem) {
  const float* mod = (const float*)(p.ws + OFF_MODZ);
  const float* x0 = layer == 0 ? p.in[0] : p.out;
  const float* x1 = layer == 0 ? p.in[1] : p.out + (size_t)TC * D;
  float* xout = p.out;
  for (int j_ = blockIdx.x >> 3; j_ < 8 * 8; j_ += gridDim.x >> 3) {
    const int mt = (blockIdx.x & 7) * 8 + (j_ & 7), nt = j_ >> 3;
    const int m0 = mt * 192, n0 = nt * 128;
    auto epi = [=](f32x16(&acc)[2], int token, int wn, int lane) {
      const int r = lane & 31, h = lane >> 5;
      {
        const float* gate = mod + (layer * 3 + tok_group(token)) * 3072 + 2048 + n0 + wn * 64;
        const float* xi = (token < TC ? x0 + (size_t)token * D : x1 + (size_t)(token - TC) * D) + n0 + wn * 64;
        float* xo = xout + (size_t)token * D + n0 + wn * 64;
#pragma unroll
        for (int fi = 0; fi < 2; fi++)
#pragma unroll
          for (int j = 0; j < 4; j++) {
            int c = fi * 32 + h * 4 + 8 * j;
            float4 g = *(const float4*)(gate + c), x = *(const float4*)(xi + c);
            *(float4*)(xo + c) = make_float4(x.x + g.x * acc[fi][4 * j], x.y + g.y * acc[fi][4 * j + 1],
                                             x.z + g.z * acc[fi][4 * j + 2], x.w + g.w * acc[fi][4 * j + 3]);
          }
      }
    };
    gemm_tile_g192<K>(A + (size_t)m0 * K, K, W + (size_t)n0 * K, K, smem, m0, epi);
  }
}

DEV void phase_mlp_inproj(const Params& p, int mi, char* smem) {
  const bf16_t* H = (const bf16_t*)(p.ws + OFF_H);
  const bf16_t* W = (const bf16_t*)(p.ws + OFF_WIN_M) + (size_t)mi * 6144 * 1024;
  bf16_t* UZ = (bf16_t*)(p.ws + OFF_UZ);
  bf16_t* GVT = (bf16_t*)(p.ws + OFF_GVT);
  float* statv = (float*)(p.ws + OFF_STATV);
  for (int j_ = blockIdx.x >> 3; j_ < 12 * 48; j_ += gridDim.x >> 3) {
    const int mt = (blockIdx.x & 7) * 12 + j_ % 12, nt = j_ / 12;
    const int m0 = mt * 128, n0 = nt * 128;
    auto epi = [=](f32x16(&acc)[2], int token, int wn, int lane) {
      const int r = lane & 31, h = lane >> 5;
      {
        if (nt < 32) {
          bf16_t* dst = UZ + (size_t)token * 2048 + nt * 64 + wn * 32;
#pragma unroll
          for (int j = 0; j < 4; j++) {
            float v0 = gelu_f(acc[0][4 * j]) * silu_f(acc[1][4 * j]);
            float v1 = gelu_f(acc[0][4 * j + 1]) * silu_f(acc[1][4 * j + 1]);
            float v2 = gelu_f(acc[0][4 * j + 2]) * silu_f(acc[1][4 * j + 2]);
            float v3 = gelu_f(acc[0][4 * j + 3]) * silu_f(acc[1][4 * j + 3]);
            *(uint2*)(dst + h * 4 + 8 * j) = make_uint2(pack2(v0, v1), pack2(v2, v3));
          }
        } else {
          const int ch0 = (nt - 32) * 128 + wn * 64;
          bf16_t* dst = GVT + ((size_t)(token >> 7) * 2048 + ch0) * 128 + (token & 127);
          float s1 = 0.f, s2 = 0.f;
#pragma unroll
          for (int fi = 0; fi < 2; fi++)
#pragma unroll
            for (int e = 0; e < 16; e++) {
              float g = gelu_f(acc[fi][e]);
              s1 += g;
              s2 += g * g;
              int ch = fi * 32 + h * 4 + 8 * (e >> 2) + (e & 3);
              dst[(size_t)ch * 128] = f2bf(g);
            }
          s1 += __shfl_xor(s1, 32);
          s2 += __shfl_xor(s2, 32);
          if (h == 0) *(float2*)(statv + ((size_t)token * 32 + (nt - 32) * 2 + wn) * 2) = make_float2(s1, s2);
        }
      }
    };
    gemm_tile_g<1024>(H + (size_t)m0 * 64, 64, W + (size_t)n0 * 64, 64, smem, m0, epi, (size_t)T * 64, (size_t)6144 * 64);
  }
}

struct LnXf {
  const float* smu;
  const float* vg;
  const float* vb;
  DEV uint4 operator()(uint4 v, int row, int kc) const {
    const float g = vg[row], b = vb[row];
    const float* mu = smu + kc;
    const float* rs = smu + 128 + kc;
    float f0 = (bflo(v.x) - mu[0]) * rs[0] * g + b, f1 = (bfhi(v.x) - mu[1]) * rs[1] * g + b;
    float f2 = (bflo(v.y) - mu[2]) * rs[2] * g + b, f3 = (bfhi(v.y) - mu[3]) * rs[3] * g + b;
    float f4 = (bflo(v.z) - mu[4]) * rs[4] * g + b, f5 = (bfhi(v.z) - mu[5]) * rs[5] * g + b;
    float f6 = (bflo(v.w) - mu[6]) * rs[6] * g + b, f7 = (bfhi(v.w) - mu[7]) * rs[7] * g + b;
    return make_uint4(pack2(f0, f1), pack2(f2, f3), pack2(f4, f5), pack2(f6, f7));
  }
};

DEV void phase_mlp_spatial(const Params& p, int mi, char* smem) {
  const bf16_t* WS = (const bf16_t*)(p.ws + OFF_WS) + (size_t)mi * 8 * 128 * 128;
  const bf16_t* GVT = (const bf16_t*)(p.ws + OFF_GVT);
  bf16_t* UZ = (bf16_t*)(p.ws + OFF_UZ);
  const float* statv = (const float*)(p.ws + OFF_STATV);
  float* smu = (float*)(smem + 2 * 2 * 128 * 72 * 2);
  for (int t = blockIdx.x; t < 96 * 16; t += gridDim.x) {
    const int c = t >> 4, g = (t >> 1) & 7, hf = t & 1;
    if (threadIdx.x < 128) {
      const float* sp = statv + (size_t)(c * 128 + threadIdx.x) * 64;
      float s1 = 0.f, s2 = 0.f;
#pragma unroll
      for (int i = 0; i < 16; i++) {
        float4 v = *(const float4*)(sp + 4 * i);
        s1 += v.x + v.z;
        s2 += v.y + v.w;
      }
      float mu = s1 * (1.f / 2048.f);
      float var = s2 * (1.f / 2048.f) - mu * mu;
      smu[threadIdx.x] = mu;
      smu[128 + threadIdx.x] = rsqrtf(fmaxf(var, 0.f) + EPS);
    }
    __syncthreads();
    const int ch0 = g * 256 + hf * 128;
    LnXf xf{smu, p.in[16] + mi * 2048 + ch0, p.in[17] + mi * 2048 + ch0};
    const float* bs = p.in[19] + (mi * 8 + g) * 128;
    auto epi = [=](f32x16(&acc)[2], int token, int wn, int lane) {
      const int r = lane & 31, h = lane >> 5;
      {
        const int pt = token;
        const float b = bs[pt];
        bf16_t* dst = UZ + (size_t)(c * 128 + pt) * 2048 + ch0 + wn * 64;
#pragma unroll
        for (int fi = 0; fi < 2; fi++)
#pragma unroll
          for (int j = 0; j < 4; j++) {
            bf16_t* ap = dst + fi * 32 + h * 4 + 8 * j;
            uint2 u = *(const uint2*)ap;
            float v0 = bflo(u.x) * (acc[fi][4 * j] + b), v1 = bfhi(u.x) * (acc[fi][4 * j + 1] + b);
            float v2 = bflo(u.y) * (acc[fi][4 * j + 2] + b), v3 = bfhi(u.y) * (acc[fi][4 * j + 3] + b);
            *(uint2*)ap = make_uint2(pack2(v0, v1), pack2(v2, v3));
          }
      }
    };
    gemm_tile<128>(WS + (size_t)g * 128 * 128, 128, GVT + ((size_t)c * 2048 + ch0) * 128, 128, smem, 0, epi, xf);
  }
}

DEV void phase_final(const Params& p) {
  const int tid_ = opaque_tid(); const int lane = tid_ & 63, w = tid_ >> 6;
  const float* fg = p.in[21];
  for (int row = blockIdx.x * 4 + w; row < T; row += gridDim.x * 4) {
    float* xr = p.out + (size_t)row * D;
    float4 v[4];
    float ss = 0.f;
#pragma unroll
    for (int i = 0; i < 4; i++) {
      v[i] = *(const float4*)(xr + i * 256 + lane * 4);
      ss += v[i].x * v[i].x + v[i].y * v[i].y + v[i].z * v[i].z + v[i].w * v[i].w;
    }
    ss = wave_sum(ss);
    const float rstd = rsqrtf(ss * (1.f / 1024.f) + EPS);
#pragma unroll
    for (int i = 0; i < 4; i++) {
      int c = i * 256 + lane * 4;
      float4 g = *(const float4*)(fg + c);
      *(float4*)(xr + c) = make_float4(v[i].x * rstd * g.x, v[i].y * rstd * g.y, v[i].z * rstd * g.z, v[i].w * rstd * g.w);
    }
  }
}

#define XB_TMO      128
#define XB_XCNT(j)  (256  + 64 * (j))
#define XB_XSUB(j)  (1280 + 64 * (j))
#define XB_XGEN(j)  (2304 + 64 * (j))
#define XB_TOP      3328
#define XB_TOPGEN   3392
#define XCD_BAR_WORDS 3456
#define XB_SPIN_CAP (1u << 18)
#define LAS __attribute__((address_space(3)))

__device__ __forceinline__ unsigned xb_ld(unsigned* p)              { return __hip_atomic_load(p, __ATOMIC_RELAXED, __HIP_MEMORY_SCOPE_AGENT); }
__device__ __forceinline__ unsigned xb_add(unsigned* p, unsigned v) { return __hip_atomic_fetch_add(p, v, __ATOMIC_RELAXED, __HIP_MEMORY_SCOPE_AGENT); }
__device__ __forceinline__ unsigned xb_xcc_id() { return (unsigned)__builtin_amdgcn_s_getreg((3 << 11) | 20) & 0xFu; }
#define XB_SPIN(cond, bar) do { unsigned _sp = 0; while (cond) { __builtin_amdgcn_s_sleep(1); \
    if ((++_sp & 255u) == 0u) { if (xb_ld(&(bar)[XB_TMO])) break; if (_sp > XB_SPIN_CAP) { atomicAdd(&(bar)[XB_TMO], 1u); break; } } } } while (0)

struct XcdBarrier {
    unsigned* bar; unsigned x;
    volatile LAS unsigned* st;
};

__device__ __forceinline__ XcdBarrier xcd_barrier_post(unsigned* bar, volatile LAS unsigned* st) {
    XcdBarrier b; b.bar = bar; b.x = xb_xcc_id(); b.st = st;
    if (threadIdx.x == 0) (void)xb_add(&bar[XB_XCNT(b.x)], 1u);
    return b;
}
__device__ __forceinline__ void xcd_barrier_complete(unsigned* bar, unsigned x, unsigned& nloc, unsigned& nx) {
    const unsigned G = gridDim.x * gridDim.y * gridDim.z;
    unsigned sum, cnt, mine, sp = 0u;
    for (;;) {
        sum = 0u; cnt = 0u; mine = 0u;
#pragma unroll
        for (unsigned j = 0; j < 16; ++j) { const unsigned c = xb_ld(&bar[XB_XCNT(j)]); sum += c; cnt += (c > 0u) ? 1u : 0u; mine = (j == x) ? c : mine; }
        if (sum == G) break;
        __builtin_amdgcn_s_sleep(1);
        if ((++sp & 255u) == 0u) { if (xb_ld(&bar[XB_TMO])) break; if (sp > XB_SPIN_CAP) { atomicAdd(&bar[XB_TMO], 1u); break; } }
    }
    nloc = mine > 0u ? mine : 1u; nx = cnt > 0u ? cnt : 1u;
}

__device__ __forceinline__ void xcd_barrier(const XcdBarrier& b) {
    asm volatile("s_waitcnt vmcnt(0)" ::: "memory");
    __syncthreads();
    if (threadIdx.x == 0) {
        unsigned* bar = b.bar;
        __builtin_amdgcn_s_waitcnt(0);
        unsigned nloc = b.st[0], nx = b.st[1];
        if (nloc == 0u) { xcd_barrier_complete(bar, b.x, nloc, nx); b.st[0] = nloc; b.st[1] = nx; }
        const unsigned old = xb_add(&bar[XB_XSUB(b.x)], 1u);
        const unsigned gen = old / nloc;
        if (old + 1u == (gen + 1u) * nloc) {
            __builtin_amdgcn_fence(__ATOMIC_RELEASE, "agent");
            asm volatile("s_waitcnt vmcnt(0)" ::: "memory");
            const unsigned og = xb_add(&bar[XB_TOP], 1u);
            const unsigned tg = og / nx;
            if (og + 1u == (tg + 1u) * nx) xb_add(&bar[XB_TOPGEN], 1u);
            else XB_SPIN(xb_ld(&bar[XB_TOPGEN]) == tg, bar);
            __builtin_amdgcn_fence(__ATOMIC_ACQUIRE, "agent");
            xb_add(&bar[XB_XGEN(b.x)], 1u);
            asm volatile("s_waitcnt vmcnt(0)" ::: "memory");
        } else {
            XB_SPIN(xb_ld(&bar[XB_XGEN(b.x)]) == gen, bar);
            __builtin_amdgcn_fence(__ATOMIC_ACQUIRE, "agent");
            asm volatile("s_waitcnt vmcnt(0)" ::: "memory");
        }
    }
    __syncthreads();
}


__global__ void __launch_bounds__(256, 2) fwd_megakernel(Params p) {
  extern __shared__ __attribute__((aligned(16))) char smem[];
  cg::grid_group grid = cg::this_grid();
  volatile LAS unsigned* xb_st = (volatile LAS unsigned*)(smem + LDS_MAIN);
  if (threadIdx.x == 0) { xb_st[0] = 0u; xb_st[1] = 0u; xb_st[2] = 0u; xb_st[3] = 0u; }
  __syncthreads();
  XcdBarrier xb = xcd_barrier_post((unsigned*)(p.ws + OFF_BAR), xb_st);
  if (p.lo < 0) grid.sync();
  int pc = 0;
#define PHASE(body)                         \
  {                                         \
    if (pc >= p.lo && pc < p.hi) {          \
      body;                                 \
      if (pc + 1 < p.hi) xcd_barrier(xb);   \
    }                                       \
    pc++;                                   \
  }
  PHASE(phase_prep(p, smem));
#pragma unroll 1
  for (int layer = 0; layer < 4; layer++) {
    const int a = layer >> 1;
    PHASE(phase_prenorm(p, layer));
    if ((layer & 1) == 0) {
      PHASE(phase_attn_inproj(p, layer, a, smem));
      PHASE(phase_attn_up(p, layer, a, smem));
      PHASE(phase_attn_core(p, a, smem));
      PHASE(phase_outproj<1024>(p, layer, (const bf16_t*)(p.ws + OFF_ZS),
                          (const bf16_t*)(p.ws + OFF_WO_A) + (size_t)a * 1024 * 1024, smem));
    } else {
      PHASE(phase_mlp_inproj(p, a, smem));
      PHASE(phase_mlp_spatial(p, a, smem));
      PHASE(phase_outproj<2048>(p, layer, (const bf16_t*)(p.ws + OFF_UZ),
                          (const bf16_t*)(p.ws + OFF_WO_M) + (size_t)a * 1024 * 2048, smem));
    }
  }
  PHASE(phase_final(p));
}

extern "C" void kernel_launch(void* const* d_in, const int* in_sizes, int n_in, void* d_out, int out_size, void* d_ws,
                              size_t ws_size, hipStream_t stream) {
  static int grid_blocks = 0;
  if (!grid_blocks) {
    hipFuncSetAttribute((const void*)fwd_megakernel, hipFuncAttributeMaxDynamicSharedMemorySize, LDS_BYTES);
    int dev = 0, cus = 0, per_cu = 0;
    hipGetDevice(&dev);
    hipDeviceGetAttribute(&cus, hipDeviceAttributeMultiprocessorCount, dev);
    hipOccupancyMaxActiveBlocksPerMultiprocessor(&per_cu, fwd_megakernel, 256, LDS_BYTES);
    if (per_cu > 2) per_cu = 2;
    if (per_cu < 1) per_cu = 1;
    grid_blocks = cus * per_cu;
  }
  Params p{};
  for (int i = 0; i < 22; i++) p.in[i] = (const float*)d_in[i];
  p.out = (float*)d_out;
  p.ws = (char*)d_ws;
  p.lo = 0;
  p.hi = 1000;
  hipMemsetAsync((char*)d_ws + OFF_BAR, 0, 16384 + SZ_MOD, stream);
  void* args[] = {&p};
  hipError_t e = hipLaunchCooperativeKernel((void*)fwd_megakernel, dim3(grid_blocks), dim3(256), args, LDS_BYTES, stream);
  if (e != hipSuccess) fprintf(stderr, "cooperative launch failed: %s (grid %d)\n", hipGetErrorString(e), grid_blocks);
}
```

```cpp
#include <hip/hip_runtime.h>
#include <hip/hip_cooperative_groups.h>
#include <stdint.h>
#include <cstdio>
namespace cg = cooperative_groups;

typedef __attribute__((ext_vector_type(8))) short bf16x8;
typedef __attribute__((ext_vector_type(16))) float f32x16;
typedef unsigned short bf16_t;

#define DEV __device__ __forceinline__

constexpr int D = 1024;
constexpr int T = 12288;
constexpr int TC = 8192;
constexpr int KT = 13312;
constexpr float EPS = 1e-6f;

constexpr size_t SZ_WIN_A = (size_t)2 * 1920 * 1024 * 2;
constexpr size_t SZ_WUQ = (size_t)2 * 1536 * 512 * 2;
constexpr size_t SZ_WUKV = (size_t)2 * 2 * 2048 * 256 * 2;
constexpr size_t SZ_WO_A = (size_t)2 * 1024 * 1024 * 2;
constexpr size_t SZ_WIN_M = (size_t)2 * 6144 * 1024 * 2;
constexpr size_t SZ_WO_M = (size_t)2 * 1024 * 2048 * 2;
constexpr size_t SZ_WS = (size_t)2 * 8 * 128 * 128 * 2;
constexpr size_t SZ_MOD = (size_t)4 * 3 * 3072 * 4;
constexpr size_t SZ_H = (size_t)T * 1024 * 2;
constexpr size_t SZ_CKVK = (size_t)2 * KT * 256 * 2;
constexpr size_t SZ_KPE = (size_t)2 * KT * 64 * 2;
constexpr size_t SZ_STATQ = (size_t)T * 8 * 4;
constexpr size_t SZ_STATKV = (size_t)T * 4 * 4;
constexpr size_t SZ_STATV = (size_t)T * 32 * 2 * 4;

constexpr size_t OFF_WIN_A = 0;
constexpr size_t OFF_WUQ = OFF_WIN_A + SZ_WIN_A;
constexpr size_t OFF_WUKV = OFF_WUQ + SZ_WUQ;
constexpr size_t OFF_WO_A = OFF_WUKV + SZ_WUKV;
constexpr size_t OFF_WIN_M = OFF_WO_A + SZ_WO_A;
constexpr size_t OFF_WO_M = OFF_WIN_M + SZ_WIN_M;
constexpr size_t OFF_WS = OFF_WO_M + SZ_WO_M;
constexpr size_t OFF_MOD = OFF_WS + SZ_WS;
constexpr size_t OFF_H = OFF_MOD + SZ_MOD;
constexpr size_t OFF_CKVK = OFF_H + SZ_H;
constexpr size_t OFF_KPE = OFF_CKVK + SZ_CKVK;
constexpr size_t OFF_STATQ = OFF_KPE + SZ_KPE;
constexpr size_t OFF_STATKV = OFF_STATQ + SZ_STATQ;
constexpr size_t OFF_STATV = OFF_STATKV + SZ_STATKV;
constexpr size_t OFF_UNION = OFF_STATV + SZ_STATV;
constexpr size_t OFF_CQ = OFF_UNION;
constexpr size_t OFF_ZS = OFF_CQ + (size_t)T * 512 * 2;
constexpr size_t OFF_Q = OFF_ZS + (size_t)T * 1024 * 2;
constexpr size_t OFF_KN = OFF_Q + (size_t)T * 1536 * 2;
constexpr size_t OFF_VT = OFF_KN + (size_t)KT * 1024 * 2;
constexpr size_t OFF_UZ = OFF_UNION;
constexpr size_t OFF_GVT = OFF_UZ + (size_t)T * 2048 * 2;

constexpr size_t OFF_BAR = OFF_VT + (size_t)KT * 1024 * 2;
constexpr size_t OFF_MODZ = OFF_BAR + 16384;
constexpr size_t WS_TOTAL = OFF_MODZ + SZ_MOD;

constexpr size_t OUT_CKV = (size_t)T * 1024;
constexpr size_t OUT_KPE = OUT_CKV + (size_t)32 * 2 * 256 * 256;

constexpr int LDS_MAIN = 2 * 2 * 128 * 72 * 2 + 1024;
constexpr int LDS_BYTES = LDS_MAIN + 16;

struct Params {
  const float* in[22];
  float* out;
  char* ws;
  int lo, hi;
};

DEV int opaque_tid() { int t = threadIdx.x; asm volatile("" : "+v"(t)); return t; }
typedef __bf16 hwbf2 __attribute__((ext_vector_type(2)));
typedef float hwf2 __attribute__((ext_vector_type(2)));
DEV unsigned pack2(float a, float b) {
  hwf2 v = {a, b};
  hwbf2 r = __builtin_convertvector(v, hwbf2);
  return *(unsigned*)&r;
}
DEV unsigned short f2bf(float f) { return (unsigned short)(pack2(f, 0.f) & 0xffffu); }
DEV float bf2f(unsigned short b) { return __uint_as_float(((unsigned)b) << 16); }
DEV float bflo(unsigned u) { return __uint_as_float(u << 16); }
DEV float bfhi(unsigned u) { return __uint_as_float(u & 0xffff0000u); }
DEV float silu_f(float x) { return x * __builtin_amdgcn_rcpf(1.f + __expf(-x)); }
DEV float gelu_f(float x) {
  float u = 0.7978845608028654f * (x + 0.044715f * x * x * x);
  return x * __builtin_amdgcn_rcpf(1.f + __expf(-2.f * u));
}
DEV int tok_group(int t) { return t < TC ? 0 : 1 + ((t - TC) >> 11); }
DEV int tok_keyrow(int t) {
  if (t < TC) return t;
  int u = t - TC;
  return TC + (u >> 11) * 2560 + 512 + (u & 2047);
}
DEV float wave_sum(float v) {
  v += __shfl_xor(v, 32);
  v += __shfl_xor(v, 16);
  v += __shfl_xor(v, 8);
  v += __shfl_xor(v, 4);
  v += __shfl_xor(v, 2);
  v += __shfl_xor(v, 1);
  return v;
}
DEV const float* xrow_in(const Params& p, int layer, int t) {
  if (layer == 0) return t < TC ? p.in[0] + (size_t)t * D : p.in[1] + (size_t)(t - TC) * D;
  return p.out + (size_t)t * D;
}

struct NoXf {
  DEV uint4 operator()(uint4 v, int row, int kc) const { return v; }
};

#define GT_LOAD(S, kt_)                                                        \
  {                                                                            \
    const bf16_t* a__ = Ap + (size_t)(kt_) * ksa;                              \
    const bf16_t* w__ = Wp + (size_t)(kt_) * ksw;                              \
    S##a0 = *(const uint4*)(a__);                                              \
    S##a1 = *(const uint4*)(a__ + (size_t)32 * lda);                           \
    S##a2 = *(const uint4*)(a__ + (size_t)64 * lda);                           \
    S##a3 = *(const uint4*)(a__ + (size_t)96 * lda);                           \
    S##w0 = *(const uint4*)(w__);                                              \
    S##w1 = *(const uint4*)(w__ + (size_t)32 * ldw);                           \
    S##w2 = *(const uint4*)(w__ + (size_t)64 * ldw);                           \
    S##w3 = *(const uint4*)(w__ + (size_t)96 * ldw);                           \
  }
#define GT_STORE(S, buf_, kt_)                                              \
  {                                                                         \
    bf16_t* dA = sA + (buf_) * 128 * 72 + lrow * 72 + lkc;                  \
    bf16_t* dW = sW + (buf_) * 128 * 72 + lrow * 72 + lkc;                  \
    *(uint4*)(dA) = S##a0;                                                  \
    *(uint4*)(dA + 32 * 72) = S##a1;                                        \
    *(uint4*)(dA + 64 * 72) = S##a2;                                        \
    *(uint4*)(dA + 96 * 72) = S##a3;                                        \
    *(uint4*)(dW) = xf(S##w0, lrow, (kt_) * 64 + lkc);                      \
    *(uint4*)(dW + 32 * 72) = xf(S##w1, lrow + 32, (kt_) * 64 + lkc);       \
    *(uint4*)(dW + 64 * 72) = xf(S##w2, lrow + 64, (kt_) * 64 + lkc);       \
    *(uint4*)(dW + 96 * 72) = xf(S##w3, lrow + 96, (kt_) * 64 + lkc);       \
  }
#define GT_LDF(dst, p_) dst = *(const bf16x8*)(p_)
#define GT_MMA4(fa0, fa1, fw0, fw1)                                                      \
  acc[0][0] = __builtin_amdgcn_mfma_f32_32x32x16_bf16(fw0, fa0, acc[0][0], 0, 0, 0);     \
  acc[0][1] = __builtin_amdgcn_mfma_f32_32x32x16_bf16(fw1, fa0, acc[0][1], 0, 0, 0);     \
  acc[1][0] = __builtin_amdgcn_mfma_f32_32x32x16_bf16(fw0, fa1, acc[1][0], 0, 0, 0);     \
  acc[1][1] = __builtin_amdgcn_mfma_f32_32x32x16_bf16(fw1, fa1, acc[1][1], 0, 0, 0);
#define GT_COMPUTE(buf_)                                                                   \
  {                                                                                        \
    const bf16_t* cA = sA + (buf_) * 128 * 72 + (wm * 64 + r) * 72 + h * 8;                \
    const bf16_t* cW = sW + (buf_) * 128 * 72 + (wn * 64 + r) * 72 + h * 8;                \
    bf16x8 xa0, xa1, xw0, xw1, ya0, ya1, yw0, yw1;                                         \
    GT_LDF(xa0, cA); GT_LDF(xw0, cW); GT_LDF(xw1, cW + 32 * 72); GT_LDF(xa1, cA + 32 * 72); \
    GT_LDF(ya0, cA + 16); GT_LDF(yw0, cW + 16); GT_LDF(yw1, cW + 32 * 72 + 16); GT_LDF(ya1, cA + 32 * 72 + 16); \
    __builtin_amdgcn_sched_barrier(0);                                                     \
    GT_MMA4(xa0, xa1, xw0, xw1)                                                            \
    __builtin_amdgcn_sched_barrier(0);                                                     \
    GT_LDF(xa0, cA + 32); GT_LDF(xw0, cW + 32); GT_LDF(xw1, cW + 32 * 72 + 32); GT_LDF(xa1, cA + 32 * 72 + 32); \
    __builtin_amdgcn_sched_barrier(0);                                                     \
    GT_MMA4(ya0, ya1, yw0, yw1)                                                            \
    __builtin_amdgcn_sched_barrier(0);                                                     \
    GT_LDF(ya0, cA + 48); GT_LDF(yw0, cW + 48); GT_LDF(yw1, cW + 32 * 72 + 48); GT_LDF(ya1, cA + 32 * 72 + 48); \
    __builtin_amdgcn_sched_barrier(0);                                                     \
    GT_MMA4(xa0, xa1, xw0, xw1)                                                            \
    GT_MMA4(ya0, ya1, yw0, yw1)                                                            \
  }

template <int K, class Epi, class Xf>
DEV void gemm_tile(const bf16_t* __restrict__ A, int lda, const bf16_t* __restrict__ W, int ldw,
                   char* smem, int m0, const Epi& epi, const Xf& xf, size_t ksa = 64, size_t ksw = 64) {
  bf16_t* sA = (bf16_t*)smem;
  bf16_t* sW = sA + 2 * 128 * 72;
  const int tid = opaque_tid(), lane = tid & 63, w = tid >> 6, wm = w & 1, wn = w >> 1;
  const int r = lane & 31, h = lane >> 5;
  f32x16 acc[2][2];
#pragma unroll
  for (int a = 0; a < 2; a++)
#pragma unroll
    for (int b = 0; b < 2; b++)
#pragma unroll
      for (int e = 0; e < 16; e++) acc[a][b][e] = 0.f;
  const int lrow = tid >> 3, lkc = (tid & 7) * 8;
  const bf16_t* Ap = A + (size_t)lrow * lda + lkc;
  const bf16_t* Wp = W + (size_t)lrow * ldw + lkc;
  uint4 Pa0, Pa1, Pa2, Pa3, Pw0, Pw1, Pw2, Pw3;
  uint4 Qa0, Qa1, Qa2, Qa3, Qw0, Qw1, Qw2, Qw3;
  constexpr int nk = K >> 6;
  GT_LOAD(P, 0);
  GT_LOAD(Q, 1);
#pragma unroll 1
  for (int kt = 0; kt < nk; kt += 2) {
    GT_STORE(P, 0, kt);
    __syncthreads();
    GT_LOAD(P, (kt + 2 < nk ? kt + 2 : nk - 2));
    GT_COMPUTE(0);
    GT_STORE(Q, 1, kt + 1);
    __syncthreads();
    GT_LOAD(Q, (kt + 3 < nk ? kt + 3 : nk - 1));
    GT_COMPUTE(1);
  }
  epi(acc[0], m0 + wm * 64 + r, wn, lane);
  epi(acc[1], m0 + wm * 64 + 32 + r, wn, lane);
  __syncthreads();
}

typedef __attribute__((address_space(3))) unsigned lds_u32_t;
#define GG_ISSUE(kt_, buf_)                                                                          \
  {                                                                                                  \
    const bf16_t* a__ = Ag + (size_t)(kt_) * ksa;                                                    \
    const bf16_t* w__ = Wg + (size_t)(kt_) * ksw;                                                    \
    char* d__ = smem + (buf_) * 32768 + w * 1024 + lane * 16;                                        \
    _Pragma("unroll") for (int i_ = 0; i_ < 4; i_++) {                                               \
      __builtin_amdgcn_global_load_lds((const unsigned*)(a__ + (size_t)(32 * i_) * lda),            \
                                       (lds_u32_t*)(d__ + i_ * 4096), 16, 0, 0);                     \
      __builtin_amdgcn_global_load_lds((const unsigned*)(w__ + (size_t)(32 * i_) * ldw),            \
                                       (lds_u32_t*)(d__ + 16384 + i_ * 4096), 16, 0, 0);             \
    }                                                                                                \
  }
#define GG_LDF(dst, base_, kk_) dst = *(const bf16x8*)((base_) + ((((kk_) * 2 + h) ^ fsw) << 4))
#define GG_COMPUTE(buf_)                                                                   \
  {                                                                                        \
    const char* cA = smem + (buf_) * 32768 + (wm * 64 + r) * 128;                          \
    const char* cW = smem + (buf_) * 32768 + 16384 + (wn * 64 + r) * 128;                  \
    bf16x8 xa0, xa1, xw0, xw1, ya0, ya1, yw0, yw1;                                         \
    GG_LDF(xa0, cA, 0); GG_LDF(xw0, cW, 0); GG_LDF(xw1, cW + 4096, 0); GG_LDF(xa1, cA + 4096, 0); \
    GG_LDF(ya0, cA, 1); GG_LDF(yw0, cW, 1); GG_LDF(yw1, cW + 4096, 1); GG_LDF(ya1, cA + 4096, 1); \
    __builtin_amdgcn_sched_barrier(0);                                                     \
    GT_MMA4(xa0, xa1, xw0, xw1)                                                            \
    __builtin_amdgcn_sched_barrier(0);                                                     \
    GG_LDF(xa0, cA, 2); GG_LDF(xw0, cW, 2); GG_LDF(xw1, cW + 4096, 2); GG_LDF(xa1, cA + 4096, 2); \
    __builtin_amdgcn_sched_barrier(0);                                                     \
    GT_MMA4(ya0, ya1, yw0, yw1)                                                            \
    __builtin_amdgcn_sched_barrier(0);                                                     \
    GG_LDF(ya0, cA, 3); GG_LDF(yw0, cW, 3); GG_LDF(yw1, cW + 4096, 3); GG_LDF(ya1, cA + 4096, 3); \
    __builtin_amdgcn_sched_barrier(0);                                                     \
    GT_MMA4(xa0, xa1, xw0, xw1)                                                            \
    GT_MMA4(ya0, ya1, yw0, yw1)                                                            \
  }

template <int K, class Epi>
DEV void gemm_tile_g(const bf16_t* __restrict__ A, int lda, const bf16_t* __restrict__ W, int ldw,
                     char* smem, int m0, const Epi& epi, size_t ksa = 64, size_t ksw = 64) {
  const int tid = opaque_tid(), lane = tid & 63, w = tid >> 6, wm = w & 1, wn = w >> 1;
  const int r = lane & 31, h = lane >> 5;
  const int fsw = (r >> 1) & 7;
  f32x16 acc[2][2];
#pragma unroll
  for (int a = 0; a < 2; a++)
#pragma unroll
    for (int b = 0; b < 2; b++)
#pragma unroll
      for (int e = 0; e < 16; e++) acc[a][b][e] = 0.f;
  const int lrow8 = lane >> 3;
  const int lchunk = (lane & 7) ^ ((((w & 1) << 2) + (lrow8 >> 1)) & 7);
  const bf16_t* Ag = A + (size_t)(w * 8 + lrow8) * lda + lchunk * 8;
  const bf16_t* Wg = W + (size_t)(w * 8 + lrow8) * ldw + lchunk * 8;
  constexpr int nk = K >> 6;
  GG_ISSUE(0, 0);
#pragma unroll 1
  for (int kt = 0; kt < nk; kt += 2) {
    asm volatile("s_waitcnt vmcnt(0)" ::: "memory");
    __syncthreads();
    GG_ISSUE(kt + 1, 1);
    GG_COMPUTE(0);
    asm volatile("s_waitcnt vmcnt(0)" ::: "memory");
    __syncthreads();
    if (kt + 2 < nk) GG_ISSUE(kt + 2, 0);
    GG_COMPUTE(1);
  }
  epi(acc[0], m0 + wm * 64 + r, wn, lane);
  epi(acc[1], m0 + wm * 64 + 32 + r, wn, lane);
  __syncthreads();
}

#define G9_STAGE 20480
#define G9_ISSUE(s_, buf_)                                                                              \
  {                                                                                                     \
    const size_t ko_ = (size_t)((s_) >> 1) * ksa + ((s_) & 1) * 32;                                     \
    const size_t kw_ = (size_t)((s_) >> 1) * ksw + ((s_) & 1) * 32;                                     \
    char* d__ = smem + (buf_) * G9_STAGE + w * 1024 + lane * 16;                                        \
    _Pragma("unroll") for (int i_ = 0; i_ < 3; i_++)                                                    \
      __builtin_amdgcn_global_load_lds((const unsigned*)(Ag + (size_t)(64 * i_) * lda + ko_),          \
                                       (lds_u32_t*)(d__ + i_ * 4096), 16, 0, 0);                        \
    _Pragma("unroll") for (int i_ = 0; i_ < 2; i_++)                                                    \
      __builtin_amdgcn_global_load_lds((const unsigned*)(Wg + (size_t)(64 * i_) * ldw + kw_),          \
                                       (lds_u32_t*)(d__ + 12288 + i_ * 4096), 16, 0, 0);                \
  }

template <int K, class Epi>
DEV void gemm_tile_g192(const bf16_t* __restrict__ A, int lda, const bf16_t* __restrict__ W, int ldw,
                        char* smem, int m0, const Epi& epi, size_t ksa = 64, size_t ksw = 64) {
  const int tid = opaque_tid(), lane = tid & 63, w = tid >> 6, wm = w & 1, wn = w >> 1;
  const int r = lane & 31, h = lane >> 5;
  const int fsw = (r >> 2) & 3;
  f32x16 acc[3][2];
#pragma unroll
  for (int a = 0; a < 3; a++)
#pragma unroll
    for (int b = 0; b < 2; b++)
#pragma unroll
      for (int e = 0; e < 16; e++) acc[a][b][e] = 0.f;
  const int lrow16 = lane >> 2;
  const int lchunk = (lane & 3) ^ ((lane >> 4) & 3);
  const bf16_t* Ag = A + (size_t)(w * 16 + lrow16) * lda + lchunk * 8;
  const bf16_t* Wg = W + (size_t)(w * 16 + lrow16) * ldw + lchunk * 8;
  constexpr int nk = K >> 5;
  asm volatile("s_waitcnt vmcnt(0)" ::: "memory");
  G9_ISSUE(0, 0);
  G9_ISSUE(1, 1);
  int buf = 0;
  const int aoff = (wm * 96 + r) * 64, woff = 12288 + (wn * 64 + r) * 64;
  const int c0 = ((0 + h) ^ fsw) << 4, c1 = ((2 + h) ^ fsw) << 4;
#pragma unroll 1
  for (int s_ = 0; s_ < nk; s_++) {
    if (s_ + 1 < nk) asm volatile("s_waitcnt vmcnt(5)" ::: "memory");
    else asm volatile("s_waitcnt vmcnt(0)" ::: "memory");
    __builtin_amdgcn_s_barrier();
    asm volatile("" ::: "memory");
    if (s_ + 2 < nk) {
      const int nb = buf >= 1 ? buf - 1 : 2;
      G9_ISSUE(s_ + 2, nb);
    }
    const char* cA = smem + buf * G9_STAGE + aoff;
    const char* cW = smem + buf * G9_STAGE + woff;
    {
      bf16x8 a0 = *(const bf16x8*)(cA + c0), a1 = *(const bf16x8*)(cA + 2048 + c0), a2 = *(const bf16x8*)(cA + 4096 + c0);
      bf16x8 w0 = *(const bf16x8*)(cW + c0), w1 = *(const bf16x8*)(cW + 2048 + c0);
      bf16x8 b0 = *(const bf16x8*)(cA + c1), b1 = *(const bf16x8*)(cA + 2048 + c1), b2 = *(const bf16x8*)(cA + 4096 + c1);
      bf16x8 v0 = *(const bf16x8*)(cW + c1), v1 = *(const bf16x8*)(cW + 2048 + c1);
      __builtin_amdgcn_sched_barrier(0);
      acc[0][0] = __builtin_amdgcn_mfma_f32_32x32x16_bf16(w0, a0, acc[0][0], 0, 0, 0);
      acc[0][1] = __builtin_amdgcn_mfma_f32_32x32x16_bf16(w1, a0, acc[0][1], 0, 0, 0);
      acc[1][0] = __builtin_amdgcn_mfma_f32_32x32x16_bf16(w0, a1, acc[1][0], 0, 0, 0);
      acc[1][1] = __builtin_amdgcn_mfma_f32_32x32x16_bf16(w1, a1, acc[1][1], 0, 0, 0);
      acc[2][0] = __builtin_amdgcn_mfma_f32_32x32x16_bf16(w0, a2, acc[2][0], 0, 0, 0);
      acc[2][1] = __builtin_amdgcn_mfma_f32_32x32x16_bf16(w1, a2, acc[2][1], 0, 0, 0);
      __builtin_amdgcn_sched_barrier(0);
      acc[0][0] = __builtin_amdgcn_mfma_f32_32x32x16_bf16(v0, b0, acc[0][0], 0, 0, 0);
      acc[0][1] = __builtin_amdgcn_mfma_f32_32x32x16_bf16(v1, b0, acc[0][1], 0, 0, 0);
      acc[1][0] = __builtin_amdgcn_mfma_f32_32x32x16_bf16(v0, b1, acc[1][0], 0, 0, 0);
      acc[1][1] = __builtin_amdgcn_mfma_f32_32x32x16_bf16(v1, b1, acc[1][1], 0, 0, 0);
      acc[2][0] = __builtin_amdgcn_mfma_f32_32x32x16_bf16(v0, b2, acc[2][0], 0, 0, 0);
      acc[2][1] = __builtin_amdgcn_mfma_f32_32x32x16_bf16(v1, b2, acc[2][1], 0, 0, 0);
    }
    buf = buf == 2 ? 0 : buf + 1;
  }
#pragma unroll
  for (int ti = 0; ti < 3; ti++) epi(acc[ti], m0 + wm * 96 + ti * 32 + r, wn, lane);
  __syncthreads();
}

DEV void rope_pair(f32x16& a, int pos, int h) {
#pragma unroll
  for (int j = 0; j < 2; j++)
#pragma unroll
    for (int i = 0; i < 4; i++) {
      int f = h * 4 + 8 * j + i;
      float inv = __builtin_amdgcn_exp2f(-(float)f * 0.8304820237218406f);
      float ang = (float)pos * inv;
      float sn, cs;
      __sincosf(ang, &sn, &cs);
      float x1 = a[4 * j + i], x2 = a[4 * (j + 2) + i];
      a[4 * j + i] = x1 * cs - x2 * sn;
      a[4 * (j + 2) + i] = x1 * sn + x2 * cs;
    }
}

DEV int perm_src(int mode, int np) {
  if (mode == 0) {
    if (np < 768) return np;
    if (np < 1792) return np + 64;
    if (np < 1856) return np - 1024;
    return -1;
  } else if (mode == 1) {
    if (np < 4096) {
      int c = np >> 6, rr = np & 63;
      return rr < 32 ? 32 * c + rr : 4096 + 32 * c + (rr - 32);
    }
    return 2048 + (np - 4096);
  }
  return np;
}

DEV void transpose_tile(const float* __restrict__ src, int N, bf16_t* __restrict__ dst, int K, int np0, int k0,
                        int mode, const float* __restrict__ kscale, float* tile, int tm_rows = 0) {
  const int tid = opaque_tid();
  const int tx = tid & 63, ty = tid >> 6;
  const int ns = perm_src(mode, np0 + tx);
  const float vmask = ns >= 0 ? 1.f : 0.f;
  const float* sp = src + (size_t)(k0 + ty) * N + (ns >= 0 ? ns : 0);
  float tv[16];
#pragma unroll
  for (int i = 0; i < 16; i++) tv[i] = sp[(size_t)(4 * i) * N];
  if (kscale) {
    float ks[16];
#pragma unroll
    for (int i = 0; i < 16; i++) ks[i] = kscale[k0 + ty + 4 * i];
#pragma unroll
    for (int i = 0; i < 16; i++) tv[i] *= ks[i];
  }
#pragma unroll
  for (int i = 0; i < 16; i++) tile[(ty + 4 * i) * 65 + tx] = tv[i] * vmask;
  __syncthreads();
  const int rr = tid >> 2, seg = tid & 3;
  unsigned o[8];
#pragma unroll
  for (int e = 0; e < 8; e++) {
    float a = tile[(seg * 16 + 2 * e) * 65 + rr];
    float b = tile[(seg * 16 + 2 * e + 1) * 65 + rr];
    o[e] = pack2(a, b);
  }
  uint4* dp = tm_rows ? (uint4*)(dst + ((size_t)(k0 >> 6) * tm_rows + np0 + rr) * 64 + seg * 16)
                      : (uint4*)(dst + (size_t)(np0 + rr) * K + k0 + seg * 16);
  dp[0] = make_uint4(o[0], o[1], o[2], o[3]);
  dp[1] = make_uint4(o[4], o[5], o[6], o[7]);
  __syncthreads();
}

DEV void transpose_item(const Params& p, int t, float* fl) {
  if (t < 960) {
    int l = t / 480, q = t % 480, nt = q / 16, kt = q % 16;
    transpose_tile(p.in[9] + (size_t)l * 1024 * 1856, 1856, (bf16_t*)(p.ws + OFF_WIN_A) + (size_t)l * 1920 * 1024,
                   1024, nt * 64, kt * 64, 0, nullptr, fl, 1920);
  } else if (t < 960 + 384) {
    t -= 960;
    int l = t / 192, q = t % 192, nt = q / 8, kt = q % 8;
    transpose_tile(p.in[12] + (size_t)l * 512 * 1536, 1536, (bf16_t*)(p.ws + OFF_WUQ) + (size_t)l * 1536 * 512, 512,
                   nt * 64, kt * 64, 2, p.in[10] + l * 512, fl);
  } else if (t < 960 + 384 + 512) {
    t -= 960 + 384;
    int lv = t / 128, q = t % 128, nt = q / 4, kt = q % 4;
    int l = lv >> 1, ver = lv & 1;
    transpose_tile(p.in[13] + (size_t)l * 256 * 2048, 2048, (bf16_t*)(p.ws + OFF_WUKV) + (size_t)lv * 2048 * 256, 256,
                   nt * 64, kt * 64, 2, ver == 0 ? p.in[11] + l * 256 : nullptr, fl);
  } else if (t < 960 + 384 + 512 + 512) {
    t -= 960 + 384 + 512;
    int l = t / 256, q = t % 256, nt = q / 16, kt = q % 16;
    transpose_tile(p.in[14] + (size_t)l * 1024 * 1024, 1024, (bf16_t*)(p.ws + OFF_WO_A) + (size_t)l * 1024 * 1024,
                   1024, nt * 64, kt * 64, 2, nullptr, fl);
  } else if (t < 960 + 384 + 512 + 512 + 3072) {
    t -= 960 + 384 + 512 + 512;
    int l = t / 1536, q = t % 1536, nt = q / 16, kt = q % 16;
    transpose_tile(p.in[15] + (size_t)l * 1024 * 6144, 6144, (bf16_t*)(p.ws + OFF_WIN_M) + (size_t)l * 6144 * 1024,
                   1024, nt * 64, kt * 64, 1, nullptr, fl, 6144);
  } else {
    t -= 960 + 384 + 512 + 512 + 3072;
    int l = t / 512, q = t % 512, nt = q / 32, kt = q % 32;
    transpose_tile(p.in[20] + (size_t)l * 2048 * 1024, 1024, (bf16_t*)(p.ws + OFF_WO_M) + (size_t)l * 1024 * 2048,
                   2048, nt * 64, kt * 64, 2, nullptr, fl);
  }
}

DEV void phase_prep(const Params& p, char* smem) {
  float* fl = (float*)smem;
  const int tid = opaque_tid(), lane = tid & 63, w = tid >> 6;
  constexpr int N_MOD = 384, N_TR = 1184, N_WS = 128, N_CKV = 256, N_KPE = 64;
  constexpr int N_ALL = N_MOD + N_TR + N_WS + N_CKV + N_KPE;
  for (int it = blockIdx.x; it < N_ALL; it += gridDim.x) {
    if (it < N_MOD) {
      const int l = it / 96, ch = (it % 96) >> 2, kq = it & 3;
      float* sc = fl;
      float* red = fl + 3072;
      for (int i = tid; i < 3072; i += 256) {
        int g = i >> 10, k = i & 1023;
        float cv = g == 0 ? p.in[5][k] : p.in[4][(g - 1) * 1024 + k];
        sc[i] = silu_f(cv);
      }
      __syncthreads();
      const float* wm_ = p.in[7] + (size_t)l * 1024 * 3072 + ch * 128 + lane * 2;
      float a0[3] = {0.f, 0.f, 0.f}, a1[3] = {0.f, 0.f, 0.f};
#pragma unroll 16
      for (int k = kq * 256 + w * 64; k < kq * 256 + w * 64 + 64; k++) {
        float2 wv = *(const float2*)(wm_ + (size_t)k * 3072);
#pragma unroll
        for (int g = 0; g < 3; g++) {
          float s = sc[g * 1024 + k];
          a0[g] += s * wv.x;
          a1[g] += s * wv.y;
        }
      }
#pragma unroll
      for (int g = 0; g < 3; g++) {
        red[(w * 3 + g) * 128 + lane * 2] = a0[g];
        red[(w * 3 + g) * 128 + lane * 2 + 1] = a1[g];
      }
      __syncthreads();
      for (int i = tid; i < 384; i += 256) {
        int g = i >> 7, c = i & 127;
        float s = red[(0 * 3 + g) * 128 + c] + red[(1 * 3 + g) * 128 + c] + red[(2 * 3 + g) * 128 + c] +
                  red[(3 * 3 + g) * 128 + c];
        int n = ch * 128 + c;
        atomicAdd(&((float*)(p.ws + OFF_MODZ))[(l * 3 + g) * 3072 + n], s + (kq == 0 ? p.in[8][l * 3072 + n] : 0.f));
      }
      __syncthreads();
    } else if (it < N_MOD + N_TR) {
      const int i = it - N_MOD;
      const int t = i < 480 ? i : i < 672 ? 960 + (i - 480) : i < 928 ? 1344 + (i - 672) : 1856 + (i - 928);
      transpose_item(p, t, fl);
    } else {
      int t = it - N_MOD - N_TR;
      const float* src;
      bf16_t* dst;
      if (t < N_WS) {
        size_t e = (size_t)t * 2048 + tid * 8;
        src = p.in[18] + e;
        dst = (bf16_t*)(p.ws + OFF_WS) + e;
      } else if (t < N_WS + N_CKV) {
        t -= N_WS;
        size_t e = (size_t)t * 2048 + tid * 8;
        int col = e & 255;
        int rowi = (int)(e >> 8);
        int pp = rowi & 511, la = rowi >> 9, a = la & 1, lb = la >> 1;
        src = p.in[2] + e;
        dst = (bf16_t*)(p.ws + OFF_CKVK) + ((size_t)a * KT + TC + lb * 2560 + pp) * 256 + col;
      } else {
        t -= N_WS + N_CKV;
        size_t e = (size_t)t * 2048 + tid * 8;
        int col = e & 63;
        int rowi = (int)(e >> 6);
        int pp = rowi & 511, la = rowi >> 9, a = la & 1, lb = la >> 1;
        src = p.in[3] + e;
        dst = (bf16_t*)(p.ws + OFF_KPE) + ((size_t)a * KT + TC + lb * 2560 + pp) * 64 + col;
      }
      float4 v0 = *(const float4*)src, v1 = *(const float4*)(src + 4);
      *(uint4*)dst = make_uint4(pack2(v0.x, v0.y), pack2(v0.z, v0.w), pack2(v1.x, v1.y), pack2(v1.z, v1.w));
    }
  }
}

DEV void phase_prenorm(const Params& p, int layer) {
  const int tid_ = opaque_tid(); const int lane = tid_ & 63, w = tid_ >> 6;
  bf16_t* H = (bf16_t*)(p.ws + OFF_H);
  const float* mod = (const float*)(p.ws + OFF_MODZ);
  const float* ng = p.in[6] + layer * 1024;
  for (int row = blockIdx.x * 4 + w; row < T; row += gridDim.x * 4) {
    const float* xr = xrow_in(p, layer, row);
    float4 v[4];
    float ss = 0.f;
#pragma unroll
    for (int i = 0; i < 4; i++) {
      v[i] = *(const float4*)(xr + i * 256 + lane * 4);
      ss += v[i].x * v[i].x + v[i].y * v[i].y + v[i].z * v[i].z + v[i].w * v[i].w;
    }
    ss = wave_sum(ss);
    const float rstd = rsqrtf(ss * (1.f / 1024.f) + EPS);
    const float* sh = mod + (layer * 3 + tok_group(row)) * 3072;
    const float* sc = sh + 1024;
#pragma unroll
    for (int i = 0; i < 4; i++) {
      int c = i * 256 + lane * 4;
      float4 g = *(const float4*)(ng + c), s = *(const float4*)(sc + c), b = *(const float4*)(sh + c);
      float o0 = v[i].x * rstd * g.x * (1.f + s.x) + b.x;
      float o1 = v[i].y * rstd * g.y * (1.f + s.y) + b.y;
      float o2 = v[i].z * rstd * g.z * (1.f + s.z) + b.z;
      float o3 = v[i].w * rstd * g.w * (1.f + s.w) + b.w;
      *(uint2*)(H + ((size_t)(c >> 6) * T + row) * 64 + (c & 63)) = make_uint2(pack2(o0, o1), pack2(o2, o3));
    }
  }
}

DEV void phase_attn_inproj(const Params& p, int layer, int a, char* smem) {
  const bf16_t* H = (const bf16_t*)(p.ws + OFF_H);
  const bf16_t* W = (const bf16_t*)(p.ws + OFF_WIN_A) + (size_t)a * 1920 * 1024;
  bf16_t* CQ = (bf16_t*)(p.ws + OFF_CQ);
  bf16_t* ZS = (bf16_t*)(p.ws + OFF_ZS);
  bf16_t* CKVK = (bf16_t*)(p.ws + OFF_CKVK) + (size_t)a * KT * 256;
  bf16_t* KPE = (bf16_t*)(p.ws + OFF_KPE) + (size_t)a * KT * 64;
  float* statq = (float*)(p.ws + OFF_STATQ);
  float* statkv = (float*)(p.ws + OFF_STATKV);
  float* out_kpe = p.out + OUT_KPE;
  for (int j_ = blockIdx.x >> 3; j_ < 12 * 15; j_ += gridDim.x >> 3) {
    const int mt = (blockIdx.x & 7) * 12 + j_ % 12, nt = j_ / 12;
    const int m0 = mt * 128, n0 = nt * 128;
    auto epi = [=](f32x16(&acc)[2], int token, int wn, int lane) {
      const int r = lane & 31, h = lane >> 5;
      {
        if (nt < 6) {
          float ss = 0.f;
          bf16_t* dst = nt < 4 ? CQ + (size_t)token * 512 + n0 + wn * 64
                               : CKVK + (size_t)tok_keyrow(token) * 256 + (n0 - 512) + wn * 64;
#pragma unroll
          for (int fi = 0; fi < 2; fi++)
#pragma unroll
            for (int j = 0; j < 4; j++) {
              float v0 = acc[fi][4 * j], v1 = acc[fi][4 * j + 1], v2 = acc[fi][4 * j + 2],
                    v3 = acc[fi][4 * j + 3];
              ss += v0 * v0 + v1 * v1 + v2 * v2 + v3 * v3;
              *(uint2*)(dst + fi * 32 + h * 4 + 8 * j) = make_uint2(pack2(v0, v1), pack2(v2, v3));
            }
          ss += __shfl_xor(ss, 32);
          if (h == 0) {
            if (nt < 4) statq[token * 8 + nt * 2 + wn] = ss;
            else statkv[token * 4 + (nt - 4) * 2 + wn] = ss;
          }
        } else if (nt < 14) {
          bf16_t* dst = ZS + (size_t)token * 1024 + (n0 - 768) + wn * 64;
#pragma unroll
          for (int fi = 0; fi < 2; fi++)
#pragma unroll
            for (int j = 0; j < 4; j++) {
              float v0 = silu_f(acc[fi][4 * j]), v1 = silu_f(acc[fi][4 * j + 1]),
                    v2 = silu_f(acc[fi][4 * j + 2]), v3 = silu_f(acc[fi][4 * j + 3]);
              *(uint2*)(dst + fi * 32 + h * 4 + 8 * j) = make_uint2(pack2(v0, v1), pack2(v2, v3));
            }
        } else if (wn == 0) {
          if (token < TC) {
            float* od = out_kpe + ((size_t)((token >> 8) * 2 + a) * 256 + (token & 255)) * 64;
#pragma unroll
            for (int fi = 0; fi < 2; fi++)
#pragma unroll
              for (int j = 0; j < 4; j++)
                *(float4*)(od + fi * 32 + h * 4 + 8 * j) =
                    make_float4(acc[fi][4 * j], acc[fi][4 * j + 1], acc[fi][4 * j + 2], acc[fi][4 * j + 3]);
          } else {
            int s = (token - TC) & 2047;
            rope_pair(acc[0], s >> 6, h);
            rope_pair(acc[1], s & 63, h);
          }
          bf16_t* dst = KPE + (size_t)tok_keyrow(token) * 64;
#pragma unroll
          for (int fi = 0; fi < 2; fi++)
#pragma unroll
            for (int j = 0; j < 4; j++)
              *(uint2*)(dst + fi * 32 + h * 4 + 8 * j) =
                  make_uint2(pack2(acc[fi][4 * j], acc[fi][4 * j + 1]), pack2(acc[fi][4 * j + 2], acc[fi][4 * j + 3]));
        }
      }
    };
    gemm_tile_g<1024>(H + (size_t)m0 * 64, 64, W + (size_t)n0 * 64, 64, smem, m0, epi, (size_t)T * 64, (size_t)1920 * 64);
  }
}

DEV void phase_attn_up(const Params& p, int layer, int a, char* smem) {
  const bf16_t* CQ = (const bf16_t*)(p.ws + OFF_CQ);
  const bf16_t* WUQ = (const bf16_t*)(p.ws + OFF_WUQ) + (size_t)a * 1536 * 512;
  const bf16_t* CKVK = (const bf16_t*)(p.ws + OFF_CKVK) + (size_t)a * KT * 256;
  bf16_t* Q = (bf16_t*)(p.ws + OFF_Q);
  bf16_t* KN = (bf16_t*)(p.ws + OFF_KN);
  bf16_t* VT = (bf16_t*)(p.ws + OFF_VT);
  const float* statq = (const float*)(p.ws + OFF_STATQ);
  const float* statkv = (const float*)(p.ws + OFF_STATKV);
  constexpr int NQ = 96 * 12, NKV = 104 * 16, NCK = 128;
  const float qscale = 0.07216878364870322f * 1.4426950408889634f;
  const int xcd_ = blockIdx.x & 7;
  for (int t = blockIdx.x >> 3; t < (NQ + NKV + NCK) / 8; t += gridDim.x >> 3) {
    if (t < NQ / 8) {
      const int mt = xcd_ * 12 + t % 12, nt = t / 12;
      const int m0 = mt * 128, n0 = nt * 128;
      auto epi = [=](f32x16(&acc)[2], int token, int wn, int lane) {
        const int r = lane & 31, h = lane >> 5;
        const int b64 = (n0 + wn * 64) >> 6;
        const bool ropeblk = (b64 % 3) == 2;
        {
          const float4 s0 = *(const float4*)(statq + token * 8), s1 = *(const float4*)(statq + token * 8 + 4);
          const float ss = s0.x + s0.y + s0.z + s0.w + s1.x + s1.y + s1.z + s1.w;
          const float sc = rsqrtf(ss * (1.f / 512.f) + EPS) * qscale;
#pragma unroll
          for (int fi = 0; fi < 2; fi++)
#pragma unroll
            for (int e = 0; e < 16; e++) acc[fi][e] *= sc;
          if (ropeblk && token >= TC) {
            int s = (token - TC) & 2047;
            rope_pair(acc[0], s >> 6, h);
            rope_pair(acc[1], s & 63, h);
          }
          bf16_t* dst = Q + (size_t)token * 1536 + n0 + wn * 64;
#pragma unroll
          for (int fi = 0; fi < 2; fi++)
#pragma unroll
            for (int j = 0; j < 4; j++)
              *(uint2*)(dst + fi * 32 + h * 4 + 8 * j) =
                  make_uint2(pack2(acc[fi][4 * j], acc[fi][4 * j + 1]), pack2(acc[fi][4 * j + 2], acc[fi][4 * j + 3]));
        }
      };
      gemm_tile_g<512>(CQ + (size_t)m0 * 512, 512, WUQ + (size_t)n0 * 512, 512, smem, m0, epi);
    } else if (t < (NQ + NKV) / 8) {
      const int tt = t - NQ / 8;
      const int mt = xcd_ * 13 + tt % 13, nt = tt / 13;
      const int m0 = mt * 128, n0 = nt * 128;
      const bool isCache = (m0 >= TC) && (((m0 - TC) % 2560) < 512);
      const bf16_t* WUKV = (const bf16_t*)(p.ws + OFF_WUKV) + (size_t)(a * 2 + (isCache ? 1 : 0)) * 2048 * 256;
      const int head = nt >> 1;
      auto epi = [=](f32x16(&acc)[2], int token, int wn, int lane) {
        const int r = lane & 31, h = lane >> 5;
        {
          const int krow = token;
          float sc = 1.f;
          if (!isCache) {
            int token = krow;
            if (krow >= TC) {
              int u = krow - TC;
              int lb = u / 2560;
              token = TC + lb * 2048 + (u - lb * 2560 - 512);
            }
            const float4 s0 = *(const float4*)(statkv + token * 4);
            sc = rsqrtf((s0.x + s0.y + s0.z + s0.w) * (1.f / 256.f) + EPS);
          }
          if ((nt & 1) == 0) {
            bf16_t* dst = KN + (size_t)krow * 1024 + head * 128 + wn * 64;
#pragma unroll
            for (int fi = 0; fi < 2; fi++)
#pragma unroll
              for (int j = 0; j < 4; j++)
                *(uint2*)(dst + fi * 32 + h * 4 + 8 * j) =
                    make_uint2(pack2(acc[fi][4 * j] * sc, acc[fi][4 * j + 1] * sc),
                               pack2(acc[fi][4 * j + 2] * sc, acc[fi][4 * j + 3] * sc));
          } else {
            bf16_t* dst = VT + (size_t)(head * 128 + wn * 64) * KT + krow;
#pragma unroll
            for (int fi = 0; fi < 2; fi++)
#pragma unroll
              for (int e = 0; e < 16; e++) {
                int dv = fi * 32 + h * 4 + 8 * (e >> 2) + (e & 3);
                dst[(size_t)dv * KT] = f2bf(acc[fi][e] * sc);
              }
          }
        }
      };
      gemm_tile_g<256>(CKVK + (size_t)m0 * 256, 256, WUKV + (size_t)n0 * 256, 256, smem, m0, epi);
    } else {
      const int tt = xcd_ * 16 + (t - (NQ + NKV) / 8);
      const float* gk = p.in[11] + a * 256;
      float* oc = p.out + OUT_CKV;
      for (int i = threadIdx.x; i < 64 * 32; i += 256) {
        int token = tt * 64 + (i >> 5), c = (i & 31) * 8;
        const float4 s0 = *(const float4*)(statkv + token * 4);
        const float sc = rsqrtf((s0.x + s0.y + s0.z + s0.w) * (1.f / 256.f) + EPS);
        uint4 v = *(const uint4*)(CKVK + (size_t)token * 256 + c);
        float4 g0 = *(const float4*)(gk + c), g1 = *(const float4*)(gk + c + 4);
        float* od = oc + ((size_t)((token >> 8) * 2 + a) * 256 + (token & 255)) * 256 + c;
        *(float4*)od = make_float4(bflo(v.x) * sc * g0.x, bfhi(v.x) * sc * g0.y, bflo(v.y) * sc * g0.z, bfhi(v.y) * sc * g0.w);
        *(float4*)(od + 4) = make_float4(bflo(v.z) * sc * g1.x, bfhi(v.z) * sc * g1.y, bflo(v.w) * sc * g1.z, bfhi(v.w) * sc * g1.w);
      }
    }
  }
}

DEV void phase_attn_core(const Params& p, int a, char* smem) {
  const bf16_t* Q = (const bf16_t*)(p.ws + OFF_Q);
  const bf16_t* KN = (const bf16_t*)(p.ws + OFF_KN);
  const bf16_t* VT = (const bf16_t*)(p.ws + OFF_VT);
  const bf16_t* KPE = (const bf16_t*)(p.ws + OFF_KPE) + (size_t)a * KT * 64;
  bf16_t* ZS = (bf16_t*)(p.ws + OFF_ZS);
  bf16_t* sK = (bf16_t*)smem;
  bf16_t* sV = sK + 64 * 200;
  const int tid = opaque_tid(), lane = tid & 63, w = tid >> 6, r = lane & 31, h = lane >> 5;
  const int qh = w;
  const int xcd = blockIdx.x & 7, nloc = gridDim.x >> 3, local = blockIdx.x >> 3, nheavy = nloc >> 1;
  const bool heavyblk = local < nheavy;
  const int istart = heavyblk ? local : local - nheavy;
  const int istep = heavyblk ? nheavy : nloc - nheavy;
  const int iend = heavyblk ? 32 : 64;
  for (int item = istart; item < iend; item += istep) {
    int head, tq0, kr0, nkt;
    if (heavyblk) {
      int pair = xcd * 2 + (item >> 4);
      int lb = pair >> 3;
      head = pair & 7;
      tq0 = TC + lb * 2048 + (item & 15) * 128;
      kr0 = TC + lb * 2560;
      nkt = 40;
    } else {
      int pair = xcd * 32 + (item >> 1);
      int b = pair >> 3;
      head = pair & 7;
      tq0 = b * 256 + (item & 1) * 128;
      kr0 = b * 256;
      nkt = 4;
    }
    bf16x8 qf[12];
    {
      const bf16_t* qp = Q + (size_t)(tq0 + qh * 32 + r) * 1536 + head * 192 + h * 8;
#pragma unroll
      for (int kk = 0; kk < 12; kk++) qf[kk] = *(const bf16x8*)(qp + kk * 16);
    }
    f32x16 o[4];
#pragma unroll
    for (int d = 0; d < 4; d++)
#pragma unroll
      for (int e = 0; e < 16; e++) o[d][e] = 0.f;
    float m = -1e30f, l = 0.f;
    uint4 rk0, rk1, rk2, rv0, rv1;
    const int krow_ = tid >> 3, kpart = tid & 7, vrow = tid >> 1, vhalf = tid & 1;
    const bf16_t* kn_p = KN + (size_t)(kr0 + krow_) * 1024 + head * 128 + kpart * 16;
    const bf16_t* kpe_p = KPE + (size_t)(kr0 + krow_) * 64 + kpart * 8;
    const bf16_t* vt_p = VT + (size_t)(head * 128 + vrow) * KT + kr0 + vhalf * 16;
    bf16_t* sKb = (bf16_t*)smem;
    bf16_t* sVb = sKb + 2 * 32 * 200;
#define AGLOAD(t_)                                                      \
  {                                                                     \
    const bf16_t* a_ = kn_p + (size_t)(t_) * 32 * 1024;                 \
    rk0 = *(const uint4*)(a_);                                          \
    rk1 = *(const uint4*)(a_ + 8);                                      \
    rk2 = *(const uint4*)(kpe_p + (size_t)(t_) * 32 * 64);              \
    const bf16_t* c_ = vt_p + (t_) * 32;                                \
    rv0 = *(const uint4*)(c_);                                          \
    rv1 = *(const uint4*)(c_ + 8);                                      \
  }
#define ASTORE(buf_)                                                    \
  {                                                                     \
    bf16_t* d_ = sKb + (buf_) * 32 * 200 + krow_ * 200;                 \
    *(uint4*)(d_ + kpart * 16) = rk0;                                   \
    *(uint4*)(d_ + kpart * 16 + 8) = rk1;                               \
    *(uint4*)(d_ + 128 + kpart * 8) = rk2;                              \
    bf16_t* f_ = sVb + (buf_) * 128 * 40 + vrow * 40 + vhalf * 16;      \
    *(uint4*)(f_) = rv0;                                                \
    *(uint4*)(f_ + 8) = rv1;                                            \
  }
    const int nt32 = nkt * 2;
    AGLOAD(0);
    ASTORE(0);
    AGLOAD(1);
    for (int t = 0; t < nt32; t++) {
      __syncthreads();
      if (t + 1 < nt32) {
        ASTORE((t + 1) & 1);
        if (t + 2 < nt32) AGLOAD(t + 2);
      }
      const bf16_t* sK = sKb + (t & 1) * 32 * 200;
      const bf16_t* sV = sVb + (t & 1) * 128 * 40;
      f32x16 sv;
#pragma unroll
      for (int e = 0; e < 16; e++) sv[e] = 0.f;
#define ALDV(d_, s2_) ({ union { bf16x8 v; uint2 u[2]; } t_; const bf16_t* vp_ = vbase + (d_) * 1280 + 16 * (s2_); \
                         t_.u[0] = *(const uint2*)vp_; t_.u[1] = *(const uint2*)(vp_ + 8); t_.v; })
      const bf16_t* kp = sK + r * 200 + h * 8;
      const bf16_t* vbase = sV + r * 40 + 4 * h;
      bf16x8 kq0 = *(const bf16x8*)(kp), kq1 = *(const bf16x8*)(kp + 16), kq2 = *(const bf16x8*)(kp + 32),
             kq3 = *(const bf16x8*)(kp + 48);
#pragma unroll
      for (int kk = 0; kk < 12; kk += 4) {
        __builtin_amdgcn_sched_barrier(0);
        sv = __builtin_amdgcn_mfma_f32_32x32x16_bf16(kq0, qf[kk], sv, 0, 0, 0);
        if (kk + 4 < 12) kq0 = *(const bf16x8*)(kp + (kk + 4) * 16);
        __builtin_amdgcn_sched_barrier(0);
        sv = __builtin_amdgcn_mfma_f32_32x32x16_bf16(kq1, qf[kk + 1], sv, 0, 0, 0);
        if (kk + 4 < 12) kq1 = *(const bf16x8*)(kp + (kk + 5) * 16);
        __builtin_amdgcn_sched_barrier(0);
        sv = __builtin_amdgcn_mfma_f32_32x32x16_bf16(kq2, qf[kk + 2], sv, 0, 0, 0);
        if (kk + 4 < 12) kq2 = *(const bf16x8*)(kp + (kk + 6) * 16);
        __builtin_amdgcn_sched_barrier(0);
        sv = __builtin_amdgcn_mfma_f32_32x32x16_bf16(kq3, qf[kk + 3], sv, 0, 0, 0);
        if (kk + 4 < 12) kq3 = *(const bf16x8*)(kp + (kk + 7) * 16);
      }
      __builtin_amdgcn_sched_barrier(0);
      bf16x8 va = ALDV(0, 0), vb = ALDV(1, 0), vc = ALDV(2, 0), vd = ALDV(3, 0);
      __builtin_amdgcn_sched_barrier(0);
      float mx = sv[0];
#pragma unroll
      for (int e = 1; e < 16; e++) mx = fmaxf(mx, sv[e]);
      mx = fmaxf(mx, __shfl_xor(mx, 32));
      const float mnew = fmaxf(m, mx);
      const float alpha = __builtin_amdgcn_exp2f(m - mnew);
      m = mnew;
      float ps = 0.f;
#pragma unroll
      for (int e = 0; e < 16; e++) {
        float pv = __builtin_amdgcn_exp2f(sv[e] - mnew);
        sv[e] = pv;
        ps += pv;
      }
      l = l * alpha + ps;
      if (!__all(alpha == 1.f)) {
#pragma unroll
        for (int d = 0; d < 4; d++)
#pragma unroll
          for (int e = 0; e < 16; e++) o[d][e] *= alpha;
      }
      union { bf16x8 v; unsigned u[4]; } pf0, pf1;
#pragma unroll
      for (int e = 0; e < 4; e++) {
        pf0.u[e] = pack2(sv[2 * e], sv[2 * e + 1]);
        pf1.u[e] = pack2(sv[8 + 2 * e], sv[8 + 2 * e + 1]);
      }
      __builtin_amdgcn_sched_barrier(0);
      o[0] = __builtin_amdgcn_mfma_f32_32x32x16_bf16(va, pf0.v, o[0], 0, 0, 0);
      va = ALDV(0, 1);
      __builtin_amdgcn_sched_barrier(0);
      o[1] = __builtin_amdgcn_mfma_f32_32x32x16_bf16(vb, pf0.v, o[1], 0, 0, 0);
      vb = ALDV(1, 1);
      __builtin_amdgcn_sched_barrier(0);
      o[2] = __builtin_amdgcn_mfma_f32_32x32x16_bf16(vc, pf0.v, o[2], 0, 0, 0);
      vc = ALDV(2, 1);
      __builtin_amdgcn_sched_barrier(0);
      o[3] = __builtin_amdgcn_mfma_f32_32x32x16_bf16(vd, pf0.v, o[3], 0, 0, 0);
      vd = ALDV(3, 1);
      __builtin_amdgcn_sched_barrier(0);
      o[0] = __builtin_amdgcn_mfma_f32_32x32x16_bf16(va, pf1.v, o[0], 0, 0, 0);
      o[1] = __builtin_amdgcn_mfma_f32_32x32x16_bf16(vb, pf1.v, o[1], 0, 0, 0);
      o[2] = __builtin_amdgcn_mfma_f32_32x32x16_bf16(vc, pf1.v, o[2], 0, 0, 0);
      o[3] = __builtin_amdgcn_mfma_f32_32x32x16_bf16(vd, pf1.v, o[3], 0, 0, 0);
    }
    __syncthreads();
    {
    l += __shfl_xor(l, 32);
    const float inv = 1.f / l;
    bf16_t* zp = ZS + (size_t)(tq0 + qh * 32 + r) * 1024 + head * 128;
#pragma unroll
    for (int d = 0; d < 4; d++)
#pragma unroll
      for (int j = 0; j < 4; j++) {
        bf16_t* ap = zp + d * 32 + h * 4 + 8 * j;
        uint2 z = *(const uint2*)ap;
        float v0 = o[d][4 * j] * inv * bflo(z.x), v1 = o[d][4 * j + 1] * inv * bfhi(z.x);
        float v2 = o[d][4 * j + 2] * inv * bflo(z.y), v3 = o[d][4 * j + 3] * inv * bfhi(z.y);
        *(uint2*)ap = make_uint2(pack2(v0, v1), pack2(v2, v3));
      }
    }
  }
  if (!heavyblk) {
    __syncthreads();
    const int nlight = 8 * (nloc - nheavy), rank = xcd + 8 * (local - nheavy);
    const int nitems = a == 0 ? 3232 : 2048;
    for (int j = rank; j < nitems; j += nlight) {
      const int i = a == 0 ? (j < 2720 ? j : 4256 + (j - 2720)) : (j < 1536 ? 2720 + j : 4768 + (j - 1536));
      const int t = i < 480 ? 480 + i : i < 672 ? 1152 + (i - 480) : i < 928 ? 1600 + (i - 672)
                                    : i < 1184 ? 2112 + (i - 928) : 2368 + (i - 1184);
      transpose_item(p, t, (float*)smem);
    }
  }
}

template <int K>
DEV void phase_outproj(const Params& p, int layer, const bf16_t* A, const bf16_t* W, char* smem) {
  const float* mod = (const float*)(p.ws + OFF_MODZ);
  const float* x0 = layer == 0 ? p.in[0] : p.out;
  const float* x1 = layer == 0 ? p.in[1] : p.out + (size_t)TC * D;
  float* xout = p.out;
  for (int j_ = blockIdx.x >> 3; j_ < 8 * 8; j_ += gridDim.x >> 3) {
    const int mt = (blockIdx.x & 7) * 8 + (j_ & 7), nt = j_ >> 3;
    const int m0 = mt * 192, n0 = nt * 128;
    auto epi = [=](f32x16(&acc)[2], int token, int wn, int lane) {
      const int r = lane & 31, h = lane >> 5;
      {
        const float* gate = mod + (layer * 3 + tok_group(token)) * 3072 + 2048 + n0 + wn * 64;
        const float* xi = (token < TC ? x0 + (size_t)token * D : x1 + (size_t)(token - TC) * D) + n0 + wn * 64;
        float* xo = xout + (size_t)token * D + n0 + wn * 64;
#pragma unroll
        for (int fi = 0; fi < 2; fi++)
#pragma unroll
          for (int j = 0; j < 4; j++) {
            int c = fi * 32 + h * 4 + 8 * j;
            float4 g = *(const float4*)(gate + c), x = *(const float4*)(xi + c);
            *(float4*)(xo + c) = make_float4(x.x + g.x * acc[fi][4 * j], x.y + g.y * acc[fi][4 * j + 1],
                                             x.z + g.z * acc[fi][4 * j + 2], x.w + g.w * acc[fi][4 * j + 3]);
          }
      }
    };
    gemm_tile_g192<K>(A + (size_t)m0 * K, K, W + (size_t)n0 * K, K, smem, m0, epi);
  }
}

DEV void phase_mlp_inproj(const Params& p, int mi, char* smem) {
  const bf16_t* H = (const bf16_t*)(p.ws + OFF_H);
  const bf16_t* W = (const bf16_t*)(p.ws + OFF_WIN_M) + (size_t)mi * 6144 * 1024;
  bf16_t* UZ = (bf16_t*)(p.ws + OFF_UZ);
  bf16_t* GVT = (bf16_t*)(p.ws + OFF_GVT);
  float* statv = (float*)(p.ws + OFF_STATV);
  for (int j_ = blockIdx.x >> 3; j_ < 12 * 48; j_ += gridDim.x >> 3) {
    const int mt = (blockIdx.x & 7) * 12 + j_ % 12, nt = j_ / 12;
    const int m0 = mt * 128, n0 = nt * 128;
    auto epi = [=](f32x16(&acc)[2], int token, int wn, int lane) {
      const int r = lane & 31, h = lane >> 5;
      {
        if (nt < 32) {
          bf16_t* dst = UZ + (size_t)token * 2048 + nt * 64 + wn * 32;
#pragma unroll
          for (int j = 0; j < 4; j++) {
            float v0 = gelu_f(acc[0][4 * j]) * silu_f(acc[1][4 * j]);
            float v1 = gelu_f(acc[0][4 * j + 1]) * silu_f(acc[1][4 * j + 1]);
            float v2 = gelu_f(acc[0][4 * j + 2]) * silu_f(acc[1][4 * j + 2]);
            float v3 = gelu_f(acc[0][4 * j + 3]) * silu_f(acc[1][4 * j + 3]);
            *(uint2*)(dst + h * 4 + 8 * j) = make_uint2(pack2(v0, v1), pack2(v2, v3));
          }
        } else {
          const int ch0 = (nt - 32) * 128 + wn * 64;
          bf16_t* dst = GVT + ((size_t)(token >> 7) * 2048 + ch0) * 128 + (token & 127);
          float s1 = 0.f, s2 = 0.f;
#pragma unroll
          for (int fi = 0; fi < 2; fi++)
#pragma unroll
            for (int e = 0; e < 16; e++) {
              float g = gelu_f(acc[fi][e]);
              s1 += g;
              s2 += g * g;
              int ch = fi * 32 + h * 4 + 8 * (e >> 2) + (e & 3);
              dst[(size_t)ch * 128] = f2bf(g);
            }
          s1 += __shfl_xor(s1, 32);
          s2 += __shfl_xor(s2, 32);
          if (h == 0) *(float2*)(statv + ((size_t)token * 32 + (nt - 32) * 2 + wn) * 2) = make_float2(s1, s2);
        }
      }
    };
    gemm_tile_g<1024>(H + (size_t)m0 * 64, 64, W + (size_t)n0 * 64, 64, smem, m0, epi, (size_t)T * 64, (size_t)6144 * 64);
  }
}

struct LnXf {
  const float* smu;
  const float* vg;
  const float* vb;
  DEV uint4 operator()(uint4 v, int row, int kc) const {
    const float g = vg[row], b = vb[row];
    const float* mu = smu + kc;
    const float* rs = smu + 128 + kc;
    float f0 = (bflo(v.x) - mu[0]) * rs[0] * g + b, f1 = (bfhi(v.x) - mu[1]) * rs[1] * g + b;
    float f2 = (bflo(v.y) - mu[2]) * rs[2] * g + b, f3 = (bfhi(v.y) - mu[3]) * rs[3] * g + b;
    float f4 = (bflo(v.z) - mu[4]) * rs[4] * g + b, f5 = (bfhi(v.z) - mu[5]) * rs[5] * g + b;
    float f6 = (bflo(v.w) - mu[6]) * rs[6] * g + b, f7 = (bfhi(v.w) - mu[7]) * rs[7] * g + b;
    return make_uint4(pack2(f0, f1), pack2(f2, f3), pack2(f4, f5), pack2(f6, f7));
  }
};

DEV void phase_mlp_spatial(const Params& p, int mi, char* smem) {
  const bf16_t* WS = (const bf16_t*)(p.ws + OFF_WS) + (size_t)mi * 8 * 128 * 128;
  const bf16_t* GVT = (const bf16_t*)(p.ws + OFF_GVT);
  bf16_t* UZ = (bf16_t*)(p.ws + OFF_UZ);
  const float* statv = (const float*)(p.ws + OFF_STATV);
  float* smu = (float*)(smem + 2 * 2 * 128 * 72 * 2);
  for (int t = blockIdx.x; t < 96 * 16; t += gridDim.x) {
    const int c = t >> 4, g = (t >> 1) & 7, hf = t & 1;
    if (threadIdx.x < 128) {
      const float* sp = statv + (size_t)(c * 128 + threadIdx.x) * 64;
      float s1 = 0.f, s2 = 0.f;
#pragma unroll
      for (int i = 0; i < 16; i++) {
        float4 v = *(const float4*)(sp + 4 * i);
        s1 += v.x + v.z;
        s2 += v.y + v.w;
      }
      float mu = s1 * (1.f / 2048.f);
      float var = s2 * (1.f / 2048.f) - mu * mu;
      smu[threadIdx.x] = mu;
      smu[128 + threadIdx.x] = rsqrtf(fmaxf(var, 0.f) + EPS);
    }
    __syncthreads();
    const int ch0 = g * 256 + hf * 128;
    LnXf xf{smu, p.in[16] + mi * 2048 + ch0, p.in[17] + mi * 2048 + ch0};
    const float* bs = p.in[19] + (mi * 8 + g) * 128;
    auto epi = [=](f32x16(&acc)[2], int token, int wn, int lane) {
      const int r = lane & 31, h = lane >> 5;
      {
        const int pt = token;
        const float b = bs[pt];
        bf16_t* dst = UZ + (size_t)(c * 128 + pt) * 2048 + ch0 + wn * 64;
#pragma unroll
        for (int fi = 0; fi < 2; fi++)
#pragma unroll
          for (int j = 0; j < 4; j++) {
            bf16_t* ap = dst + fi * 32 + h * 4 + 8 * j;
            uint2 u = *(const uint2*)ap;
            float v0 = bflo(u.x) * (acc[fi][4 * j] + b), v1 = bfhi(u.x) * (acc[fi][4 * j + 1] + b);
            float v2 = bflo(u.y) * (acc[fi][4 * j + 2] + b), v3 = bfhi(u.y) * (acc[fi][4 * j + 3] + b);
            *(uint2*)ap = make_uint2(pack2(v0, v1), pack2(v2, v3));
          }
      }
    };
    gemm_tile<128>(WS + (size_t)g * 128 * 128, 128, GVT + ((size_t)c * 2048 + ch0) * 128, 128, smem, 0, epi, xf);
  }
}

DEV void phase_final(const Params& p) {
  const int tid_ = opaque_tid(); const int lane = tid_ & 63, w = tid_ >> 6;
  const float* fg = p.in[21];
  for (int row = blockIdx.x * 4 + w; row < T; row += gridDim.x * 4) {
    float* xr = p.out + (size_t)row * D;
    float4 v[4];
    float ss = 0.f;
#pragma unroll
    for (int i = 0; i < 4; i++) {
      v[i] = *(const float4*)(xr + i * 256 + lane * 4);
      ss += v[i].x * v[i].x + v[i].y * v[i].y + v[i].z * v[i].z + v[i].w * v[i].w;
    }
    ss = wave_sum(ss);
    const float rstd = rsqrtf(ss * (1.f / 1024.f) + EPS);
#pragma unroll
    for (int i = 0; i < 4; i++) {
      int c = i * 256 + lane * 4;
      float4 g = *(const float4*)(fg + c);
      *(float4*)(xr + c) = make_float4(v[i].x * rstd * g.x, v[i].y * rstd * g.y, v[i].z * rstd * g.z, v[i].w * rstd * g.w);
    }
  }
}

#define XB_TMO      128
#define XB_XCNT(j)  (256  + 64 * (j))
#define XB_XSUB(j)  (1280 + 64 * (j))
#define XB_XGEN(j)  (2304 + 64 * (j))
#define XB_TOP      3328
#define XB_TOPGEN   3392
#define XCD_BAR_WORDS 3456
#define XB_SPIN_CAP (1u << 18)
#define LAS __attribute__((address_space(3)))

__device__ __forceinline__ unsigned xb_ld(unsigned* p)              { return __hip_atomic_load(p, __ATOMIC_RELAXED, __HIP_MEMORY_SCOPE_AGENT); }
__device__ __forceinline__ unsigned xb_add(unsigned* p, unsigned v) { return __hip_atomic_fetch_add(p, v, __ATOMIC_RELAXED, __HIP_MEMORY_SCOPE_AGENT); }
__device__ __forceinline__ unsigned xb_xcc_id() { return (unsigned)__builtin_amdgcn_s_getreg((3 << 11) | 20) & 0xFu; }
#define XB_SPIN(cond, bar) do { unsigned _sp = 0; while (cond) { __builtin_amdgcn_s_sleep(1); \
    if ((++_sp & 255u) == 0u) { if (xb_ld(&(bar)[XB_TMO])) break; if (_sp > XB_SPIN_CAP) { atomicAdd(&(bar)[XB_TMO], 1u); break; } } } } while (0)

struct XcdBarrier {
    unsigned* bar; unsigned x;
    volatile LAS unsigned* st;
};

__device__ __forceinline__ XcdBarrier xcd_barrier_post(unsigned* bar, volatile LAS unsigned* st) {
    XcdBarrier b; b.bar = bar; b.x = xb_xcc_id(); b.st = st;
    if (threadIdx.x == 0) (void)xb_add(&bar[XB_XCNT(b.x)], 1u);
    return b;
}
__device__ __forceinline__ void xcd_barrier_complete(unsigned* bar, unsigned x, unsigned& nloc, unsigned& nx) {
    const unsigned G = gridDim.x * gridDim.y * gridDim.z;
    unsigned sum, cnt, mine, sp = 0u;
    for (;;) {
        sum = 0u; cnt = 0u; mine = 0u;
#pragma unroll
        for (unsigned j = 0; j < 16; ++j) { const unsigned c = xb_ld(&bar[XB_XCNT(j)]); sum += c; cnt += (c > 0u) ? 1u : 0u; mine = (j == x) ? c : mine; }
        if (sum == G) break;
        __builtin_amdgcn_s_sleep(1);
        if ((++sp & 255u) == 0u) { if (xb_ld(&bar[XB_TMO])) break; if (sp > XB_SPIN_CAP) { atomicAdd(&bar[XB_TMO], 1u); break; } }
    }
    nloc = mine > 0u ? mine : 1u; nx = cnt > 0u ? cnt : 1u;
}

__device__ __forceinline__ void xcd_barrier(const XcdBarrier& b) {
    asm volatile("s_waitcnt vmcnt(0)" ::: "memory");
    __syncthreads();
    if (threadIdx.x == 0) {
        unsigned* bar = b.bar;
        __builtin_amdgcn_s_waitcnt(0);
        unsigned nloc = b.st[0], nx = b.st[1];
        if (nloc == 0u) { xcd_barrier_complete(bar, b.x, nloc, nx); b.st[0] = nloc; b.st[1] = nx; }
        const unsigned old = xb_add(&bar[XB_XSUB(b.x)], 1u);
        const unsigned gen = old / nloc;
        if (old + 1u == (gen + 1u) * nloc) {
            __builtin_amdgcn_fence(__ATOMIC_RELEASE, "agent");
            asm volatile("s_waitcnt vmcnt(0)" ::: "memory");
            const unsigned og = xb_add(&bar[XB_TOP], 1u);
            const unsigned tg = og / nx;
            if (og + 1u == (tg + 1u) * nx) xb_add(&bar[XB_TOPGEN], 1u);
            else XB_SPIN(xb_ld(&bar[XB_TOPGEN]) == tg, bar);
            __builtin_amdgcn_fence(__ATOMIC_ACQUIRE, "agent");
            xb_add(&bar[XB_XGEN(b.x)], 1u);
            asm volatile("s_waitcnt vmcnt(0)" ::: "memory");
        } else {
            XB_SPIN(xb_ld(&bar[XB_XGEN(b.x)]) == gen, bar);
            __builtin_amdgcn_fence(__ATOMIC_ACQUIRE, "agent");
            asm volatile("s_waitcnt vmcnt(0)" ::: "memory");
        }
    }
    __syncthreads();
}


__global__ void __launch_bounds__(256, 2) fwd_megakernel(Params p) {
  extern __shared__ __attribute__((aligned(16))) char smem[];
  cg::grid_group grid = cg::this_grid();
  volatile LAS unsigned* xb_st = (volatile LAS unsigned*)(smem + LDS_MAIN);
  if (threadIdx.x == 0) { xb_st[0] = 0u; xb_st[1] = 0u; xb_st[2] = 0u; xb_st[3] = 0u; }
  __syncthreads();
  XcdBarrier xb = xcd_barrier_post((unsigned*)(p.ws + OFF_BAR), xb_st);
  if (p.lo < 0) grid.sync();
  int pc = 0;
#define PHASE(body)                         \
  {                                         \
    if (pc >= p.lo && pc < p.hi) {          \
      body;                                 \
      if (pc + 1 < p.hi) xcd_barrier(xb);   \
    }                                       \
    pc++;                                   \
  }
  PHASE(phase_prep(p, smem));
#pragma unroll 1
  for (int layer = 0; layer < 4; layer++) {
    const int a = layer >> 1;
    PHASE(phase_prenorm(p, layer));
    if ((layer & 1) == 0) {
      PHASE(phase_attn_inproj(p, layer, a, smem));
      PHASE(phase_attn_up(p, layer, a, smem));
      PHASE(phase_attn_core(p, a, smem));
      PHASE(phase_outproj<1024>(p, layer, (const bf16_t*)(p.ws + OFF_ZS),
                          (const bf16_t*)(p.ws + OFF_WO_A) + (size_t)a * 1024 * 1024, smem));
    } else {
      PHASE(phase_mlp_inproj(p, a, smem));
      PHASE(phase_mlp_spatial(p, a, smem));
      PHASE(phase_outproj<2048>(p, layer, (const bf16_t*)(p.ws + OFF_UZ),
                          (const bf16_t*)(p.ws + OFF_WO_M) + (size_t)a * 1024 * 2048, smem));
    }
  }
  PHASE(phase_final(p));
}

extern "C" void kernel_launch(void* const* d_in, const int* in_sizes, int n_in, void* d_out, int out_size, void* d_ws,
                              size_t ws_size, hipStream_t stream) {
  static int grid_blocks = 0;
  if (!grid_blocks) {
    hipFuncSetAttribute((const void*)fwd_megakernel, hipFuncAttributeMaxDynamicSharedMemorySize, LDS_BYTES);
    int dev = 0, cus = 0, per_cu = 0;
    hipGetDevice(&dev);
    hipDeviceGetAttribute(&cus, hipDeviceAttributeMultiprocessorCount, dev);
    hipOccupancyMaxActiveBlocksPerMultiprocessor(&per_cu, fwd_megakernel, 256, LDS_BYTES);
    if (per_cu > 2) per_cu = 2;
    if (per_cu < 1) per_cu = 1;
    grid_blocks = cus * per_cu;
  }
  Params p{};
  for (int i = 0; i < 22; i++) p.in[i] = (const float*)d_in[i];
  p.out = (float*)d_out;
  p.ws = (char*)d_ws;
  p.lo = 0;
  p.hi = 1000;
  hipMemsetAsync((char*)d_ws + OFF_BAR, 0, 16384 + SZ_MOD, stream);
  void* args[] = {&p};
  hipError_t e = hipLaunchCooperativeKernel((void*)fwd_megakernel, dim3(grid_blocks), dim3(256), args, LDS_BYTES, stream);
  if (e != hipSuccess) fprintf(stderr, "cooperative launch failed: %s (grid %d)\n", hipGetErrorString(e), grid_blocks);
}
```

```cpp
#include <hip/hip_runtime.h>
#include <hip/hip_cooperative_groups.h>
#include <stdint.h>
#include <cstdio>
namespace cg = cooperative_groups;

typedef __attribute__((ext_vector_type(8))) short bf16x8;
typedef __attribute__((ext_vector_type(16))) float f32x16;
typedef unsigned short bf16_t;

#define DEV __device__ __forceinline__

constexpr int D = 1024;
constexpr int T = 12288;
constexpr int TC = 8192;
constexpr int KT = 13312;
constexpr float EPS = 1e-6f;

constexpr size_t SZ_WIN_A = (size_t)2 * 1920 * 1024 * 2;
constexpr size_t SZ_WUQ = (size_t)2 * 1536 * 512 * 2;
constexpr size_t SZ_WUKV = (size_t)2 * 2 * 2048 * 256 * 2;
constexpr size_t SZ_WO_A = (size_t)2 * 1024 * 1024 * 2;
constexpr size_t SZ_WIN_M = (size_t)2 * 6144 * 1024 * 2;
constexpr size_t SZ_WO_M = (size_t)2 * 1024 * 2048 * 2;
constexpr size_t SZ_WS = (size_t)2 * 8 * 128 * 128 * 2;
constexpr size_t SZ_MOD = (size_t)4 * 3 * 3072 * 4;
constexpr size_t SZ_H = (size_t)T * 1024 * 2;
constexpr size_t SZ_CKVK = (size_t)2 * KT * 256 * 2;
constexpr size_t SZ_KPE = (size_t)2 * KT * 64 * 2;
constexpr size_t SZ_STATQ = (size_t)T * 8 * 4;
constexpr size_t SZ_STATKV = (size_t)T * 4 * 4;
constexpr size_t SZ_STATV = (size_t)T * 32 * 2 * 4;

constexpr size_t OFF_WIN_A = 0;
constexpr size_t OFF_WUQ = OFF_WIN_A + SZ_WIN_A;
constexpr size_t OFF_WUKV = OFF_WUQ + SZ_WUQ;
constexpr size_t OFF_WO_A = OFF_WUKV + SZ_WUKV;
constexpr size_t OFF_WIN_M = OFF_WO_A + SZ_WO_A;
constexpr size_t OFF_WO_M = OFF_WIN_M + SZ_WIN_M;
constexpr size_t OFF_WS = OFF_WO_M + SZ_WO_M;
constexpr size_t OFF_MOD = OFF_WS + SZ_WS;
constexpr size_t OFF_H = OFF_MOD + SZ_MOD;
constexpr size_t OFF_CKVK = OFF_H + SZ_H;
constexpr size_t OFF_KPE = OFF_CKVK + SZ_CKVK;
constexpr size_t OFF_STATQ = OFF_KPE + SZ_KPE;
constexpr size_t OFF_STATKV = OFF_STATQ + SZ_STATQ;
constexpr size_t OFF_STATV = OFF_STATKV + SZ_STATKV;
constexpr size_t OFF_UNION = OFF_STATV + SZ_STATV;
constexpr size_t OFF_CQ = OFF_UNION;
constexpr size_t OFF_ZS = OFF_CQ + (size_t)T * 512 * 2;
constexpr size_t OFF_Q = OFF_ZS + (size_t)T * 1024 * 2;
constexpr size_t OFF_KN = OFF_Q + (size_t)T * 1536 * 2;
constexpr size_t OFF_VT = OFF_KN + (size_t)KT * 1024 * 2;
constexpr size_t OFF_UZ = OFF_UNION;
constexpr size_t OFF_GVT = OFF_UZ + (size_t)T * 2048 * 2;

constexpr size_t OFF_BAR = OFF_VT + (size_t)KT * 1024 * 2;
constexpr size_t OFF_MODZ = OFF_BAR + 16384;
constexpr size_t WS_TOTAL = OFF_MODZ + SZ_MOD;

constexpr size_t OUT_CKV = (size_t)T * 1024;
constexpr size_t OUT_KPE = OUT_CKV + (size_t)32 * 2 * 256 * 256;

constexpr int LDS_MAIN = 2 * 2 * 128 * 72 * 2 + 1024;
constexpr int LDS_BYTES = LDS_MAIN + 16;

struct Params {
  const float* in[22];
  float* out;
  char* ws;
  int lo, hi;
};

DEV int opaque_tid() { int t = threadIdx.x; asm volatile("" : "+v"(t)); return t; }
typedef __bf16 hwbf2 __attribute__((ext_vector_type(2)));
typedef float hwf2 __attribute__((ext_vector_type(2)));
DEV unsigned pack2(float a, float b) {
  hwf2 v = {a, b};
  hwbf2 r = __builtin_convertvector(v, hwbf2);
  return *(unsigned*)&r;
}
DEV unsigned short f2bf(float f) { return (unsigned short)(pack2(f, 0.f) & 0xffffu); }
DEV float bf2f(unsigned short b) { return __uint_as_float(((unsigned)b) << 16); }
DEV float bflo(unsigned u) { return __uint_as_float(u << 16); }
DEV float bfhi(unsigned u) { return __uint_as_float(u & 0xffff0000u); }
DEV float silu_f(float x) { return x * __builtin_amdgcn_rcpf(1.f + __expf(-x)); }
DEV float gelu_f(float x) {
  float u = 0.7978845608028654f * (x + 0.044715f * x * x * x);
  return x * __builtin_amdgcn_rcpf(1.f + __expf(-2.f * u));
}
DEV int tok_group(int t) { return t < TC ? 0 : 1 + ((t - TC) >> 11); }
DEV int tok_keyrow(int t) {
  if (t < TC) return t;
  int u = t - TC;
  return TC + (u >> 11) * 2560 + 512 + (u & 2047);
}
DEV float wave_sum(float v) {
  v += __shfl_xor(v, 32);
  v += __shfl_xor(v, 16);
  v += __shfl_xor(v, 8);
  v += __shfl_xor(v, 4);
  v += __shfl_xor(v, 2);
  v += __shfl_xor(v, 1);
  return v;
}
DEV const float* xrow_in(const Params& p, int layer, int t) {
  if (layer == 0) return t < TC ? p.in[0] + (size_t)t * D : p.in[1] + (size_t)(t - TC) * D;
  return p.out + (size_t)t * D;
}

struct NoXf {
  DEV uint4 operator()(uint4 v, int row, int kc) const { return v; }
};

#define GT_LOAD(S, kt_)                                                        \
  {                                                                            \
    const bf16_t* a__ = Ap + (size_t)(kt_) * ksa;                              \
    const bf16_t* w__ = Wp + (size_t)(kt_) * ksw;                              \
    S##a0 = *(const uint4*)(a__);                                              \
    S##a1 = *(const uint4*)(a__ + (size_t)32 * lda);                           \
    S##a2 = *(const uint4*)(a__ + (size_t)64 * lda);                           \
    S##a3 = *(const uint4*)(a__ + (size_t)96 * lda);                           \
    S##w0 = *(const uint4*)(w__);                                              \
    S##w1 = *(const uint4*)(w__ + (size_t)32 * ldw);                           \
    S##w2 = *(const uint4*)(w__ + (size_t)64 * ldw);                           \
    S##w3 = *(const uint4*)(w__ + (size_t)96 * ldw);                           \
  }
#define GT_STORE(S, buf_, kt_)                                              \
  {                                                                         \
    bf16_t* dA = sA + (buf_) * 128 * 72 + lrow * 72 + lkc;                  \
    bf16_t* dW = sW + (buf_) * 128 * 72 + lrow * 72 + lkc;                  \
    *(uint4*)(dA) = S##a0;                                                  \
    *(uint4*)(dA + 32 * 72) = S##a1;                                        \
    *(uint4*)(dA + 64 * 72) = S##a2;                                        \
    *(uint4*)(dA + 96 * 72) = S##a3;                                        \
    *(uint4*)(dW) = xf(S##w0, lrow, (kt_) * 64 + lkc);                      \
    *(uint4*)(dW + 32 * 72) = xf(S##w1, lrow + 32, (kt_) * 64 + lkc);       \
    *(uint4*)(dW + 64 * 72) = xf(S##w2, lrow + 64, (kt_) * 64 + lkc);       \
    *(uint4*)(dW + 96 * 72) = xf(S##w3, lrow + 96, (kt_) * 64 + lkc);       \
  }
#define GT_LDF(dst, p_) dst = *(const bf16x8*)(p_)
#define GT_MMA4(fa0, fa1, fw0, fw1)                                                      \
  acc[0][0] = __builtin_amdgcn_mfma_f32_32x32x16_bf16(fw0, fa0, acc[0][0], 0, 0, 0);     \
  acc[0][1] = __builtin_amdgcn_mfma_f32_32x32x16_bf16(fw1, fa0, acc[0][1], 0, 0, 0);     \
  acc[1][0] = __builtin_amdgcn_mfma_f32_32x32x16_bf16(fw0, fa1, acc[1][0], 0, 0, 0);     \
  acc[1][1] = __builtin_amdgcn_mfma_f32_32x32x16_bf16(fw1, fa1, acc[1][1], 0, 0, 0);
#define GT_COMPUTE(buf_)                                                                   \
  {                                                                                        \
    const bf16_t* cA = sA + (buf_) * 128 * 72 + (wm * 64 + r) * 72 + h * 8;                \
    const bf16_t* cW = sW + (buf_) * 128 * 72 + (wn * 64 + r) * 72 + h * 8;                \
    bf16x8 xa0, xa1, xw0, xw1, ya0, ya1, yw0, yw1;                                         \
    GT_LDF(xa0, cA); GT_LDF(xw0, cW); GT_LDF(xw1, cW + 32 * 72); GT_LDF(xa1, cA + 32 * 72); \
    GT_LDF(ya0, cA + 16); GT_LDF(yw0, cW + 16); GT_LDF(yw1, cW + 32 * 72 + 16); GT_LDF(ya1, cA + 32 * 72 + 16); \
    __builtin_amdgcn_sched_barrier(0);                                                     \
    GT_MMA4(xa0, xa1, xw0, xw1)                                                            \
    __builtin_amdgcn_sched_barrier(0);                                                     \
    GT_LDF(xa0, cA + 32); GT_LDF(xw0, cW + 32); GT_LDF(xw1, cW + 32 * 72 + 32); GT_LDF(xa1, cA + 32 * 72 + 32); \
    __builtin_amdgcn_sched_barrier(0);                                                     \
    GT_MMA4(ya0, ya1, yw0, yw1)                                                            \
    __builtin_amdgcn_sched_barrier(0);                                                     \
    GT_LDF(ya0, cA + 48); GT_LDF(yw0, cW + 48); GT_LDF(yw1, cW + 32 * 72 + 48); GT_LDF(ya1, cA + 32 * 72 + 48); \
    __builtin_amdgcn_sched_barrier(0);                                                     \
    GT_MMA4(xa0, xa1, xw0, xw1)                                                            \
    GT_MMA4(ya0, ya1, yw0, yw1)                                                            \
  }

template <int K, class Epi, class Xf>
DEV void gemm_tile(const bf16_t* __restrict__ A, int lda, const bf16_t* __restrict__ W, int ldw,
                   char* smem, int m0, const Epi& epi, const Xf& xf, size_t ksa = 64, size_t ksw = 64) {
  bf16_t* sA = (bf16_t*)smem;
  bf16_t* sW = sA + 2 * 128 * 72;
  const int tid = opaque_tid(), lane = tid & 63, w = tid >> 6, wm = w & 1, wn = w >> 1;
  const int r = lane & 31, h = lane >> 5;
  f32x16 acc[2][2];
#pragma unroll
  for (int a = 0; a < 2; a++)
#pragma unroll
    for (int b = 0; b < 2; b++)
#pragma unroll
      for (int e = 0; e < 16; e++) acc[a][b][e] = 0.f;
  const int lrow = tid >> 3, lkc = (tid & 7) * 8;
  const bf16_t* Ap = A + (size_t)lrow * lda + lkc;
  const bf16_t* Wp = W + (size_t)lrow * ldw + lkc;
  uint4 Pa0, Pa1, Pa2, Pa3, Pw0, Pw1, Pw2, Pw3;
  uint4 Qa0, Qa1, Qa2, Qa3, Qw0, Qw1, Qw2, Qw3;
  constexpr int nk = K >> 6;
  GT_LOAD(P, 0);
  GT_LOAD(Q, 1);
#pragma unroll 1
  for (int kt = 0; kt < nk; kt += 2) {
    GT_STORE(P, 0, kt);
    __syncthreads();
    GT_LOAD(P, (kt + 2 < nk ? kt + 2 : nk - 2));
    GT_COMPUTE(0);
    GT_STORE(Q, 1, kt + 1);
    __syncthreads();
    GT_LOAD(Q, (kt + 3 < nk ? kt + 3 : nk - 1));
    GT_COMPUTE(1);
  }
  epi(acc[0], m0 + wm * 64 + r, wn, lane);
  epi(acc[1], m0 + wm * 64 + 32 + r, wn, lane);
  __syncthreads();
}

typedef __attribute__((address_space(3))) unsigned lds_u32_t;
#define GG_ISSUE(kt_, buf_)                                                                          \
  {                                                                                                  \
    const bf16_t* a__ = Ag + (size_t)(kt_) * ksa;                                                    \
    const bf16_t* w__ = Wg + (size_t)(kt_) * ksw;                                                    \
    char* d__ = smem + (buf_) * 32768 + w * 1024 + lane * 16;                                        \
    _Pragma("unroll") for (int i_ = 0; i_ < 4; i_++) {                                               \
      __builtin_amdgcn_global_load_lds((const unsigned*)(a__ + (size_t)(32 * i_) * lda),            \
                                       (lds_u32_t*)(d__ + i_ * 4096), 16, 0, 0);                     \
      __builtin_amdgcn_global_load_lds((const unsigned*)(w__ + (size_t)(32 * i_) * ldw),            \
                                       (lds_u32_t*)(d__ + 16384 + i_ * 4096), 16, 0, 0);             \
    }                                                                                                \
  }
#define GG_LDF(dst, base_, kk_) dst = *(const bf16x8*)((base_) + ((((kk_) * 2 + h) ^ fsw) << 4))
#define GG_COMPUTE(buf_)                                                                   \
  {                                                                                        \
    const char* cA = smem + (buf_) * 32768 + (wm * 64 + r) * 128;                          \
    const char* cW = smem + (buf_) * 32768 + 16384 + (wn * 64 + r) * 128;                  \
    bf16x8 xa0, xa1, xw0, xw1, ya0, ya1, yw0, yw1;                                         \
    GG_LDF(xa0, cA, 0); GG_LDF(xw0, cW, 0); GG_LDF(xw1, cW + 4096, 0); GG_LDF(xa1, cA + 4096, 0); \
    GG_LDF(ya0, cA, 1); GG_LDF(yw0, cW, 1); GG_LDF(yw1, cW + 4096, 1); GG_LDF(ya1, cA + 4096, 1); \
    __builtin_amdgcn_sched_barrier(0);                                                     \
    GT_MMA4(xa0, xa1, xw0, xw1)                                                            \
    __builtin_amdgcn_sched_barrier(0);                                                     \
    GG_LDF(xa0, cA, 2); GG_LDF(xw0, cW, 2); GG_LDF(xw1, cW + 4096, 2); GG_LDF(xa1, cA + 4096, 2); \
    __builtin_amdgcn_sched_barrier(0);                                                     \
    GT_MMA4(ya0, ya1, yw0, yw1)                                                            \
    __builtin_amdgcn_sched_barrier(0);                                                     \
    GG_LDF(ya0, cA, 3); GG_LDF(yw0, cW, 3); GG_LDF(yw1, cW + 4096, 3); GG_LDF(ya1, cA + 4096, 3); \
    __builtin_amdgcn_sched_barrier(0);                                                     \
    GT_MMA4(xa0, xa1, xw0, xw1)                                                            \
    GT_MMA4(ya0, ya1, yw0, yw1)                                                            \
  }

template <int K, class Epi>
DEV void gemm_tile_g(const bf16_t* __restrict__ A, int lda, const bf16_t* __restrict__ W, int ldw,
                     char* smem, int m0, const Epi& epi, size_t ksa = 64, size_t ksw = 64) {
  const int tid = opaque_tid(), lane = tid & 63, w = tid >> 6, wm = w & 1, wn = w >> 1;
  const int r = lane & 31, h = lane >> 5;
  const int fsw = (r >> 1) & 7;
  f32x16 acc[2][2];
#pragma unroll
  for (int a = 0; a < 2; a++)
#pragma unroll
    for (int b = 0; b < 2; b++)
#pragma unroll
      for (int e = 0; e < 16; e++) acc[a][b][e] = 0.f;
  const int lrow8 = lane >> 3;
  const int lchunk = (lane & 7) ^ ((((w & 1) << 2) + (lrow8 >> 1)) & 7);
  const bf16_t* Ag = A + (size_t)(w * 8 + lrow8) * lda + lchunk * 8;
  const bf16_t* Wg = W + (size_t)(w * 8 + lrow8) * ldw + lchunk * 8;
  constexpr int nk = K >> 6;
  GG_ISSUE(0, 0);
#pragma unroll 1
  for (int kt = 0; kt < nk; kt += 2) {
    asm volatile("s_waitcnt vmcnt(0)" ::: "memory");
    __syncthreads();
    GG_ISSUE(kt + 1, 1);
    GG_COMPUTE(0);
    asm volatile("s_waitcnt vmcnt(0)" ::: "memory");
    __syncthreads();
    if (kt + 2 < nk) GG_ISSUE(kt + 2, 0);
    GG_COMPUTE(1);
  }
  epi(acc[0], m0 + wm * 64 + r, wn, lane);
  epi(acc[1], m0 + wm * 64 + 32 + r, wn, lane);
  __syncthreads();
}

#define G9_STAGE 20480
#define G9_ISSUE(s_, buf_)                                                                              \
  {                                                                                                     \
    const size_t ko_ = (size_t)((s_) >> 1) * ksa + ((s_) & 1) * 32;                                     \
    const size_t kw_ = (size_t)((s_) >> 1) * ksw + ((s_) & 1) * 32;                                     \
    char* d__ = smem + (buf_) * G9_STAGE + w * 1024 + lane * 16;                                        \
    _Pragma("unroll") for (int i_ = 0; i_ < 3; i_++)                                                    \
      __builtin_amdgcn_global_load_lds((const unsigned*)(Ag + (size_t)(64 * i_) * lda + ko_),          \
                                       (lds_u32_t*)(d__ + i_ * 4096), 16, 0, 0);                        \
    _Pragma("unroll") for (int i_ = 0; i_ < 2; i_++)                                                    \
      __builtin_amdgcn_global_load_lds((const unsigned*)(Wg + (size_t)(64 * i_) * ldw + kw_),          \
                                       (lds_u32_t*)(d__ + 12288 + i_ * 4096), 16, 0, 0);                \
  }

template <int K, class Epi>
DEV void gemm_tile_g192(const bf16_t* __restrict__ A, int lda, const bf16_t* __restrict__ W, int ldw,
                        char* smem, int m0, const Epi& epi, size_t ksa = 64, size_t ksw = 64) {
  const int tid = opaque_tid(), lane = tid & 63, w = tid >> 6, wm = w & 1, wn = w >> 1;
  const int r = lane & 31, h = lane >> 5;
  const int fsw = (r >> 2) & 3;
  f32x16 acc[3][2];
#pragma unroll
  for (int a = 0; a < 3; a++)
#pragma unroll
    for (int b = 0; b < 2; b++)
#pragma unroll
      for (int e = 0; e < 16; e++) acc[a][b][e] = 0.f;
  const int lrow16 = lane >> 2;
  const int lchunk = (lane & 3) ^ ((lane >> 4) & 3);
  const bf16_t* Ag = A + (size_t)(w * 16 + lrow16) * lda + lchunk * 8;
  const bf16_t* Wg = W + (size_t)(w * 16 + lrow16) * ldw + lchunk * 8;
  constexpr int nk = K >> 5;
  asm volatile("s_waitcnt vmcnt(0)" ::: "memory");
  G9_ISSUE(0, 0);
  G9_ISSUE(1, 1);
  int buf = 0;
  const int aoff = (wm * 96 + r) * 64, woff = 12288 + (wn * 64 + r) * 64;
  const int c0 = ((0 + h) ^ fsw) << 4, c1 = ((2 + h) ^ fsw) << 4;
#pragma unroll 1
  for (int s_ = 0; s_ < nk; s_++) {
    if (s_ + 1 < nk) asm volatile("s_waitcnt vmcnt(5)" ::: "memory");
    else asm volatile("s_waitcnt vmcnt(0)" ::: "memory");
    __builtin_amdgcn_s_barrier();
    asm volatile("" ::: "memory");
    if (s_ + 2 < nk) {
      const int nb = buf >= 1 ? buf - 1 : 2;
      G9_ISSUE(s_ + 2, nb);
    }
    const char* cA = smem + buf * G9_STAGE + aoff;
    const char* cW = smem + buf * G9_STAGE + woff;
    {
      bf16x8 a0 = *(const bf16x8*)(cA + c0), a1 = *(const bf16x8*)(cA + 2048 + c0), a2 = *(const bf16x8*)(cA + 4096 + c0);
      bf16x8 w0 = *(const bf16x8*)(cW + c0), w1 = *(const bf16x8*)(cW + 2048 + c0);
      bf16x8 b0 = *(const bf16x8*)(cA + c1), b1 = *(const bf16x8*)(cA + 2048 + c1), b2 = *(const bf16x8*)(cA + 4096 + c1);
      bf16x8 v0 = *(const bf16x8*)(cW + c1), v1 = *(const bf16x8*)(cW + 2048 + c1);
      __builtin_amdgcn_sched_barrier(0);
      acc[0][0] = __builtin_amdgcn_mfma_f32_32x32x16_bf16(w0, a0, acc[0][0], 0, 0, 0);
      acc[0][1] = __builtin_amdgcn_mfma_f32_32x32x16_bf16(w1, a0, acc[0][1], 0, 0, 0);
      acc[1][0] = __builtin_amdgcn_mfma_f32_32x32x16_bf16(w0, a1, acc[1][0], 0, 0, 0);
      acc[1][1] = __builtin_amdgcn_mfma_f32_32x32x16_bf16(w1, a1, acc[1][1], 0, 0, 0);
      acc[2][0] = __builtin_amdgcn_mfma_f32_32x32x16_bf16(w0, a2, acc[2][0], 0, 0, 0);
      acc[2][1] = __builtin_amdgcn_mfma_f32_32x32x16_bf16(w1, a2, acc[2][1], 0, 0, 0);
      __builtin_amdgcn_sched_barrier(0);
      acc[0][0] = __builtin_amdgcn_mfma_f32_32x32x16_bf16(v0, b0, acc[0][0], 0, 0, 0);
      acc[0][1] = __builtin_amdgcn_mfma_f32_32x32x16_bf16(v1, b0, acc[0][1], 0, 0, 0);
      acc[1][0] = __builtin_amdgcn_mfma_f32_32x32x16_bf16(v0, b1, acc[1][0], 0, 0, 0);
      acc[1][1] = __builtin_amdgcn_mfma_f32_32x32x16_bf16(v1, b1, acc[1][1], 0, 0, 0);
      acc[2][0] = __builtin_amdgcn_mfma_f32_32x32x16_bf16(v0, b2, acc[2][0], 0, 0, 0);
      acc[2][1] = __builtin_amdgcn_mfma_f32_32x32x16_bf16(v1, b2, acc[2][1], 0, 0, 0);
    }
    buf = buf == 2 ? 0 : buf + 1;
  }
#pragma unroll
  for (int ti = 0; ti < 3; ti++) epi(acc[ti], m0 + wm * 96 + ti * 32 + r, wn, lane);
  __syncthreads();
}

DEV void rope_pair(f32x16& a, int pos, int h) {
#pragma unroll
  for (int j = 0; j < 2; j++)
#pragma unroll
    for (int i = 0; i < 4; i++) {
      int f = h * 4 + 8 * j + i;
      float inv = __builtin_amdgcn_exp2f(-(float)f * 0.8304820237218406f);
      float ang = (float)pos * inv;
      float sn, cs;
      __sincosf(ang, &sn, &cs);
      float x1 = a[4 * j + i], x2 = a[4 * (j + 2) + i];
      a[4 * j + i] = x1 * cs - x2 * sn;
      a[4 * (j + 2) + i] = x1 * sn + x2 * cs;
    }
}

DEV int perm_src(int mode, int np) {
  if (mode == 0) {
    if (np < 768) return np;
    if (np < 1792) return np + 64;
    if (np < 1856) return np - 1024;
    return -1;
  } else if (mode == 1) {
    if (np < 4096) {
      int c = np >> 6, rr = np & 63;
      return rr < 32 ? 32 * c + rr : 4096 + 32 * c + (rr - 32);
    }
    return 2048 + (np - 4096);
  }
  return np;
}

DEV void transpose_tile(const float* __restrict__ src, int N, bf16_t* __restrict__ dst, int K, int np0, int k0,
                        int mode, const float* __restrict__ kscale, float* tile, int tm_rows = 0) {
  const int tid = opaque_tid();
  const int tx = tid & 63, ty = tid >> 6;
  const int ns = perm_src(mode, np0 + tx);
  const float vmask = ns >= 0 ? 1.f : 0.f;
  const float* sp = src + (size_t)(k0 + ty) * N + (ns >= 0 ? ns : 0);
  float tv[16];
#pragma unroll
  for (int i = 0; i < 16; i++) tv[i] = sp[(size_t)(4 * i) * N];
  if (kscale) {
    float ks[16];
#pragma unroll
    for (int i = 0; i < 16; i++) ks[i] = kscale[k0 + ty + 4 * i];
#pragma unroll
    for (int i = 0; i < 16; i++) tv[i] *= ks[i];
  }
#pragma unroll
  for (int i = 0; i < 16; i++) tile[(ty + 4 * i) * 65 + tx] = tv[i] * vmask;
  __syncthreads();
  const int rr = tid >> 2, seg = tid & 3;
  unsigned o[8];
#pragma unroll
  for (int e = 0; e < 8; e++) {
    float a = tile[(seg * 16 + 2 * e) * 65 + rr];
    float b = tile[(seg * 16 + 2 * e + 1) * 65 + rr];
    o[e] = pack2(a, b);
  }
  uint4* dp = tm_rows ? (uint4*)(dst + ((size_t)(k0 >> 6) * tm_rows + np0 + rr) * 64 + seg * 16)
                      : (uint4*)(dst + (size_t)(np0 + rr) * K + k0 + seg * 16);
  dp[0] = make_uint4(o[0], o[1], o[2], o[3]);
  dp[1] = make_uint4(o[4], o[5], o[6], o[7]);
  __syncthreads();
}

DEV void transpose_item(const Params& p, int t, float* fl) {
  if (t < 960) {
    int l = t / 480, q = t % 480, nt = q / 16, kt = q % 16;
    transpose_tile(p.in[9] + (size_t)l * 1024 * 1856, 1856, (bf16_t*)(p.ws + OFF_WIN_A) + (size_t)l * 1920 * 1024,
                   1024, nt * 64, kt * 64, 0, nullptr, fl, 1920);
  } else if (t < 960 + 384) {
    t -= 960;
    int l = t / 192, q = t % 192, nt = q / 8, kt = q % 8;
    transpose_tile(p.in[12] + (size_t)l * 512 * 1536, 1536, (bf16_t*)(p.ws + OFF_WUQ) + (size_t)l * 1536 * 512, 512,
                   nt * 64, kt * 64, 2, p.in[10] + l * 512, fl);
  } else if (t < 960 + 384 + 512) {
    t -= 960 + 384;
    int lv = t / 128, q = t % 128, nt = q / 4, kt = q % 4;
    int l = lv >> 1, ver = lv & 1;
    transpose_tile(p.in[13] + (size_t)l * 256 * 2048, 2048, (bf16_t*)(p.ws + OFF_WUKV) + (size_t)lv * 2048 * 256, 256,
                   nt * 64, kt * 64, 2, ver == 0 ? p.in[11] + l * 256 : nullptr, fl);
  } else if (t < 960 + 384 + 512 + 512) {
    t -= 960 + 384 + 512;
    int l = t / 256, q = t % 256, nt = q / 16, kt = q % 16;
    transpose_tile(p.in[14] + (size_t)l * 1024 * 1024, 1024, (bf16_t*)(p.ws + OFF_WO_A) + (size_t)l * 1024 * 1024,
                   1024, nt * 64, kt * 64, 2, nullptr, fl);
  } else if (t < 960 + 384 + 512 + 512 + 3072) {
    t -= 960 + 384 + 512 + 512;
    int l = t / 1536, q = t % 1536, nt = q / 16, kt = q % 16;
    transpose_tile(p.in[15] + (size_t)l * 1024 * 6144, 6144, (bf16_t*)(p.ws + OFF_WIN_M) + (size_t)l * 6144 * 1024,
                   1024, nt * 64, kt * 64, 1, nullptr, fl, 6144);
  } else {
    t -= 960 + 384 + 512 + 512 + 3072;
    int l = t / 512, q = t % 512, nt = q / 32, kt = q % 32;
    transpose_tile(p.in[20] + (size_t)l * 2048 * 1024, 1024, (bf16_t*)(p.ws + OFF_WO_M) + (size_t)l * 1024 * 2048,
                   2048, nt * 64, kt * 64, 2, nullptr, fl);
  }
}

DEV void phase_prep(const Params& p, char* smem) {
  float* fl = (float*)smem;
  const int tid = opaque_tid(), lane = tid & 63, w = tid >> 6;
  constexpr int N_MOD = 384, N_TR = 1184, N_WS = 128, N_CKV = 256, N_KPE = 64;
  constexpr int N_ALL = N_MOD + N_TR + N_WS + N_CKV + N_KPE;
  for (int it = blockIdx.x; it < N_ALL; it += gridDim.x) {
    if (it < N_MOD) {
      const int l = it / 96, ch = (it % 96) >> 2, kq = it & 3;
      float* sc = fl;
      float* red = fl + 3072;
      for (int i = tid; i < 3072; i += 256) {
        int g = i >> 10, k = i & 1023;
        float cv = g == 0 ? p.in[5][k] : p.in[4][(g - 1) * 1024 + k];
        sc[i] = silu_f(cv);
      }
      __syncthreads();
      const float* wm_ = p.in[7] + (size_t)l * 1024 * 3072 + ch * 128 + lane * 2;
      float a0[3] = {0.f, 0.f, 0.f}, a1[3] = {0.f, 0.f, 0.f};
#pragma unroll 16
      for (int k = kq * 256 + w * 64; k < kq * 256 + w * 64 + 64; k++) {
        float2 wv = *(const float2*)(wm_ + (size_t)k * 3072);
#pragma unroll
        for (int g = 0; g < 3; g++) {
          float s = sc[g * 1024 + k];
          a0[g] += s * wv.x;
          a1[g] += s * wv.y;
        }
      }
#pragma unroll
      for (int g = 0; g < 3; g++) {
        red[(w * 3 + g) * 128 + lane * 2] = a0[g];
        red[(w * 3 + g) * 128 + lane * 2 + 1] = a1[g];
      }
      __syncthreads();
      for (int i = tid; i < 384; i += 256) {
        int g = i >> 7, c = i & 127;
        float s = red[(0 * 3 + g) * 128 + c] + red[(1 * 3 + g) * 128 + c] + red[(2 * 3 + g) * 128 + c] +
                  red[(3 * 3 + g) * 128 + c];
        int n = ch * 128 + c;
        atomicAdd(&((float*)(p.ws + OFF_MODZ))[(l * 3 + g) * 3072 + n], s + (kq == 0 ? p.in[8][l * 3072 + n] : 0.f));
      }
      __syncthreads();
    } else if (it < N_MOD + N_TR) {
      const int i = it - N_MOD;
      const int t = i < 480 ? i : i < 672 ? 960 + (i - 480) : i < 928 ? 1344 + (i - 672) : 1856 + (i - 928);
      transpose_item(p, t, fl);
    } else {
      int t = it - N_MOD - N_TR;
      const float* src;
      bf16_t* dst;
      if (t < N_WS) {
        size_t e = (size_t)t * 2048 + tid * 8;
        src = p.in[18] + e;
        dst = (bf16_t*)(p.ws + OFF_WS) + e;
      } else if (t < N_WS + N_CKV) {
        t -= N_WS;
        size_t e = (size_t)t * 2048 + tid * 8;
        int col = e & 255;
        int rowi = (int)(e >> 8);
        int pp = rowi & 511, la = rowi >> 9, a = la & 1, lb = la >> 1;
        src = p.in[2] + e;
        dst = (bf16_t*)(p.ws + OFF_CKVK) + ((size_t)a * KT + TC + lb * 2560 + pp) * 256 + col;
      } else {
        t -= N_WS + N_CKV;
        size_t e = (size_t)t * 2048 + tid * 8;
        int col = e & 63;
        int rowi = (int)(e >> 6);
        int pp = rowi & 511, la = rowi >> 9, a = la & 1, lb = la >> 1;
        src = p.in[3] + e;
        dst = (bf16_t*)(p.ws + OFF_KPE) + ((size_t)a * KT + TC + lb * 2560 + pp) * 64 + col;
      }
      float4 v0 = *(const float4*)src, v1 = *(const float4*)(src + 4);
      *(uint4*)dst = make_uint4(pack2(v0.x, v0.y), pack2(v0.z, v0.w), pack2(v1.x, v1.y), pack2(v1.z, v1.w));
    }
  }
}

DEV void phase_prenorm(const Params& p, int layer) {
  const int tid_ = opaque_tid(); const int lane = tid_ & 63, w = tid_ >> 6;
  bf16_t* H = (bf16_t*)(p.ws + OFF_H);
  const float* mod = (const float*)(p.ws + OFF_MODZ);
  const float* ng = p.in[6] + layer * 1024;
  for (int row = blockIdx.x * 4 + w; row < T; row += gridDim.x * 4) {
    const float* xr = xrow_in(p, layer, row);
    float4 v[4];
    float ss = 0.f;
#pragma unroll
    for (int i = 0; i < 4; i++) {
      v[i] = *(const float4*)(xr + i * 256 + lane * 4);
      ss += v[i].x * v[i].x + v[i].y * v[i].y + v[i].z * v[i].z + v[i].w * v[i].w;
    }
    ss = wave_sum(ss);
    const float rstd = rsqrtf(ss * (1.f / 1024.f) + EPS);
    const float* sh = mod + (layer * 3 + tok_group(row)) * 3072;
    const float* sc = sh + 1024;
#pragma unroll
    for (int i = 0; i < 4; i++) {
      int c = i * 256 + lane * 4;
      float4 g = *(const float4*)(ng + c), s = *(const float4*)(sc + c), b = *(const float4*)(sh + c);
      float o0 = v[i].x * rstd * g.x * (1.f + s.x) + b.x;
      float o1 = v[i].y * rstd * g.y * (1.f + s.y) + b.y;
      float o2 = v[i].z * rstd * g.z * (1.f + s.z) + b.z;
      float o3 = v[i].w * rstd * g.w * (1.f + s.w) + b.w;
      *(uint2*)(H + ((size_t)(c >> 6) * T + row) * 64 + (c & 63)) = make_uint2(pack2(o0, o1), pack2(o2, o3));
    }
  }
}

DEV void phase_attn_inproj(const Params& p, int layer, int a, char* smem) {
  const bf16_t* H = (const bf16_t*)(p.ws + OFF_H);
  const bf16_t* W = (const bf16_t*)(p.ws + OFF_WIN_A) + (size_t)a * 1920 * 1024;
  bf16_t* CQ = (bf16_t*)(p.ws + OFF_CQ);
  bf16_t* ZS = (bf16_t*)(p.ws + OFF_ZS);
  bf16_t* CKVK = (bf16_t*)(p.ws + OFF_CKVK) + (size_t)a * KT * 256;
  bf16_t* KPE = (bf16_t*)(p.ws + OFF_KPE) + (size_t)a * KT * 64;
  float* statq = (float*)(p.ws + OFF_STATQ);
  float* statkv = (float*)(p.ws + OFF_STATKV);
  float* out_kpe = p.out + OUT_KPE;
  for (int j_ = blockIdx.x >> 3; j_ < 12 * 15; j_ += gridDim.x >> 3) {
    const int mt = (blockIdx.x & 7) * 12 + j_ % 12, nt = j_ / 12;
    const int m0 = mt * 128, n0 = nt * 128;
    auto epi = [=](f32x16(&acc)[2], int token, int wn, int lane) {
      const int r = lane & 31, h = lane >> 5;
      {
        if (nt < 6) {
          float ss = 0.f;
          bf16_t* dst = nt < 4 ? CQ + (size_t)token * 512 + n0 + wn * 64
                               : CKVK + (size_t)tok_keyrow(token) * 256 + (n0 - 512) + wn * 64;
#pragma unroll
          for (int fi = 0; fi < 2; fi++)
#pragma unroll
            for (int j = 0; j < 4; j++) {
              float v0 = acc[fi][4 * j], v1 = acc[fi][4 * j + 1], v2 = acc[fi][4 * j + 2],
                    v3 = acc[fi][4 * j + 3];
              ss += v0 * v0 + v1 * v1 + v2 * v2 + v3 * v3;
              *(uint2*)(dst + fi * 32 + h * 4 + 8 * j) = make_uint2(pack2(v0, v1), pack2(v2, v3));
            }
          ss += __shfl_xor(ss, 32);
          if (h == 0) {
            if (nt < 4) statq[token * 8 + nt * 2 + wn] = ss;
            else statkv[token * 4 + (nt - 4) * 2 + wn] = ss;
          }
        } else if (nt < 14) {
          bf16_t* dst = ZS + (size_t)token * 1024 + (n0 - 768) + wn * 64;
#pragma unroll
          for (int fi = 0; fi < 2; fi++)
#pragma unroll
            for (int j = 0; j < 4; j++) {
              float v0 = silu_f(acc[fi][4 * j]), v1 = silu_f(acc[fi][4 * j + 1]),
                    v2 = silu_f(acc[fi][4 * j + 2]), v3 = silu_f(acc[fi][4 * j + 3]);
              *(uint2*)(dst + fi * 32 + h * 4 + 8 * j) = make_uint2(pack2(v0, v1), pack2(v2, v3));
            }
        } else if (wn == 0) {
          if (token < TC) {
            float* od = out_kpe + ((size_t)((token >> 8) * 2 + a) * 256 + (token & 255)) * 64;
#pragma unroll
            for (int fi = 0; fi < 2; fi++)
#pragma unroll
              for (int j = 0; j < 4; j++)
                *(float4*)(od + fi * 32 + h * 4 + 8 * j) =
                    make_float4(acc[fi][4 * j], acc[fi][4 * j + 1], acc[fi][4 * j + 2], acc[fi][4 * j + 3]);
          } else {
            int s = (token - TC) & 2047;
            rope_pair(acc[0], s >> 6, h);
            rope_pair(acc[1], s & 63, h);
          }
          bf16_t* dst = KPE + (size_t)tok_keyrow(token) * 64;
#pragma unroll
          for (int fi = 0; fi < 2; fi++)
#pragma unroll
            for (int j = 0; j < 4; j++)
              *(uint2*)(dst + fi * 32 + h * 4 + 8 * j) =
                  make_uint2(pack2(acc[fi][4 * j], acc[fi][4 * j + 1]), pack2(acc[fi][4 * j + 2], acc[fi][4 * j + 3]));
        }
      }
    };
    gemm_tile_g<1024>(H + (size_t)m0 * 64, 64, W + (size_t)n0 * 64, 64, smem, m0, epi, (size_t)T * 64, (size_t)1920 * 64);
  }
}

DEV void phase_attn_up(const Params& p, int layer, int a, char* smem) {
  const bf16_t* CQ = (const bf16_t*)(p.ws + OFF_CQ);
  const bf16_t* WUQ = (const bf16_t*)(p.ws + OFF_WUQ) + (size_t)a * 1536 * 512;
  const bf16_t* CKVK = (const bf16_t*)(p.ws + OFF_CKVK) + (size_t)a * KT * 256;
  bf16_t* Q = (bf16_t*)(p.ws + OFF_Q);
  bf16_t* KN = (bf16_t*)(p.ws + OFF_KN);
  bf16_t* VT = (bf16_t*)(p.ws + OFF_VT);
  const float* statq = (const float*)(p.ws + OFF_STATQ);
  const float* statkv = (const float*)(p.ws + OFF_STATKV);
  constexpr int NQ = 96 * 12, NKV = 104 * 16, NCK = 128;
  const float qscale = 0.07216878364870322f * 1.4426950408889634f;
  const int xcd_ = blockIdx.x & 7;
  for (int t = blockIdx.x >> 3; t < (NQ + NKV + NCK) / 8; t += gridDim.x >> 3) {
    if (t < NQ / 8) {
      const int mt = xcd_ * 12 + t % 12, nt = t / 12;
      const int m0 = mt * 128, n0 = nt * 128;
      auto epi = [=](f32x16(&acc)[2], int token, int wn, int lane) {
        const int r = lane & 31, h = lane >> 5;
        const int b64 = (n0 + wn * 64) >> 6;
        const bool ropeblk = (b64 % 3) == 2;
        {
          const float4 s0 = *(const float4*)(statq + token * 8), s1 = *(const float4*)(statq + token * 8 + 4);
          const float ss = s0.x + s0.y + s0.z + s0.w + s1.x + s1.y + s1.z + s1.w;
          const float sc = rsqrtf(ss * (1.f / 512.f) + EPS) * qscale;
#pragma unroll
          for (int fi = 0; fi < 2; fi++)
#pragma unroll
            for (int e = 0; e < 16; e++) acc[fi][e] *= sc;
          if (ropeblk && token >= TC) {
            int s = (token - TC) & 2047;
            rope_pair(acc[0], s >> 6, h);
            rope_pair(acc[1], s & 63, h);
          }
          bf16_t* dst = Q + (size_t)token * 1536 + n0 + wn * 64;
#pragma unroll
          for (int fi = 0; fi < 2; fi++)
#pragma unroll
            for (int j = 0; j < 4; j++)
              *(uint2*)(dst + fi * 32 + h * 4 + 8 * j) =
                  make_uint2(pack2(acc[fi][4 * j], acc[fi][4 * j + 1]), pack2(acc[fi][4 * j + 2], acc[fi][4 * j + 3]));
        }
      };
      gemm_tile_g<512>(CQ + (size_t)m0 * 512, 512, WUQ + (size_t)n0 * 512, 512, smem, m0, epi);
    } else if (t < (NQ + NKV) / 8) {
      const int tt = t - NQ / 8;
      const int mt = xcd_ * 13 + tt % 13, nt = tt / 13;
      const int m0 = mt * 128, n0 = nt * 128;
      const bool isCache = (m0 >= TC) && (((m0 - TC) % 2560) < 512);
      const bf16_t* WUKV = (const bf16_t*)(p.ws + OFF_WUKV) + (size_t)(a * 2 + (isCache ? 1 : 0)) * 2048 * 256;
      const int head = nt >> 1;
      auto epi = [=](f32x16(&acc)[2], int token, int wn, int lane) {
        const int r = lane & 31, h = lane >> 5;
        {
          const int krow = token;
          float sc = 1.f;
          if (!isCache) {
            int token = krow;
            if (krow >= TC) {
              int u = krow - TC;
              int lb = u / 2560;
              token = TC + lb * 2048 + (u - lb * 2560 - 512);
            }
            const float4 s0 = *(const float4*)(statkv + token * 4);
            sc = rsqrtf((s0.x + s0.y + s0.z + s0.w) * (1.f / 256.f) + EPS);
          }
          if ((nt & 1) == 0) {
            bf16_t* dst = KN + (size_t)krow * 1024 + head * 128 + wn * 64;
#pragma unroll
            for (int fi = 0; fi < 2; fi++)
#pragma unroll
              for (int j = 0; j < 4; j++)
                *(uint2*)(dst + fi * 32 + h * 4 + 8 * j) =
                    make_uint2(pack2(acc[fi][4 * j] * sc, acc[fi][4 * j + 1] * sc),
                               pack2(acc[fi][4 * j + 2] * sc, acc[fi][4 * j + 3] * sc));
          } else {
            bf16_t* dst = VT + (size_t)(head * 128 + wn * 64) * KT + krow;
#pragma unroll
            for (int fi = 0; fi < 2; fi++)
#pragma unroll
              for (int e = 0; e < 16; e++) {
                int dv = fi * 32 + h * 4 + 8 * (e >> 2) + (e & 3);
                dst[(size_t)dv * KT] = f2bf(acc[fi][e] * sc);
              }
          }
        }
      };
      gemm_tile_g<256>(CKVK + (size_t)m0 * 256, 256, WUKV + (size_t)n0 * 256, 256, smem, m0, epi);
    } else {
      const int tt = xcd_ * 16 + (t - (NQ + NKV) / 8);
      const float* gk = p.in[11] + a * 256;
      float* oc = p.out + OUT_CKV;
      for (int i = threadIdx.x; i < 64 * 32; i += 256) {
        int token = tt * 64 + (i >> 5), c = (i & 31) * 8;
        const float4 s0 = *(const float4*)(statkv + token * 4);
        const float sc = rsqrtf((s0.x + s0.y + s0.z + s0.w) * (1.f / 256.f) + EPS);
        uint4 v = *(const uint4*)(CKVK + (size_t)token * 256 + c);
        float4 g0 = *(const float4*)(gk + c), g1 = *(const float4*)(gk + c + 4);
        float* od = oc + ((size_t)((token >> 8) * 2 + a) * 256 + (token & 255)) * 256 + c;
        *(float4*)od = make_float4(bflo(v.x) * sc * g0.x, bfhi(v.x) * sc * g0.y, bflo(v.y) * sc * g0.z, bfhi(v.y) * sc * g0.w);
        *(float4*)(od + 4) = make_float4(bflo(v.z) * sc * g1.x, bfhi(v.z) * sc * g1.y, bflo(v.w) * sc * g1.z, bfhi(v.w) * sc * g1.w);
      }
    }
  }
}

DEV void phase_attn_core(const Params& p, int a, char* smem) {
  const bf16_t* Q = (const bf16_t*)(p.ws + OFF_Q);
  const bf16_t* KN = (const bf16_t*)(p.ws + OFF_KN);
  const bf16_t* VT = (const bf16_t*)(p.ws + OFF_VT);
  const bf16_t* KPE = (const bf16_t*)(p.ws + OFF_KPE) + (size_t)a * KT * 64;
  bf16_t* ZS = (bf16_t*)(p.ws + OFF_ZS);
  bf16_t* sK = (bf16_t*)smem;
  bf16_t* sV = sK + 64 * 200;
  const int tid = opaque_tid(), lane = tid & 63, w = tid >> 6, r = lane & 31, h = lane >> 5;
  const int qh = w;
  const int xcd = blockIdx.x & 7, nloc = gridDim.x >> 3, local = blockIdx.x >> 3, nheavy = nloc >> 1;
  const bool heavyblk = local < nheavy;
  const int istart = heavyblk ? local : local - nheavy;
  const int istep = heavyblk ? nheavy : nloc - nheavy;
  const int iend = heavyblk ? 32 : 64;
  for (int item = istart; item < iend; item += istep) {
    int head, tq0, kr0, nkt;
    if (heavyblk) {
      int pair = xcd * 2 + (item >> 4);
      int lb = pair >> 3;
      head = pair & 7;
      tq0 = TC + lb * 2048 + (item & 15) * 128;
      kr0 = TC + lb * 2560;
      nkt = 40;
    } else {
      int pair = xcd * 32 + (item >> 1);
      int b = pair >> 3;
      head = pair & 7;
      tq0 = b * 256 + (item & 1) * 128;
      kr0 = b * 256;
      nkt = 4;
    }
    bf16x8 qf[12];
    {
      const bf16_t* qp = Q + (size_t)(tq0 + qh * 32 + r) * 1536 + head * 192 + h * 8;
#pragma unroll
      for (int kk = 0; kk < 12; kk++) qf[kk] = *(const bf16x8*)(qp + kk * 16);
    }
    f32x16 o[4];
#pragma unroll
    for (int d = 0; d < 4; d++)
#pragma unroll
      for (int e = 0; e < 16; e++) o[d][e] = 0.f;
    float m = -1e30f, l = 0.f;
    uint4 rk0, rk1, rk2, rv0, rv1;
    const int krow_ = tid >> 3, kpart = tid & 7, vrow = tid >> 1, vhalf = tid & 1;
    const bf16_t* kn_p = KN + (size_t)(kr0 + krow_) * 1024 + head * 128 + kpart * 16;
    const bf16_t* kpe_p = KPE + (size_t)(kr0 + krow_) * 64 + kpart * 8;
    const bf16_t* vt_p = VT + (size_t)(head * 128 + vrow) * KT + kr0 + vhalf * 16;
    bf16_t* sKb = (bf16_t*)smem;
    bf16_t* sVb = sKb + 2 * 32 * 200;
#define AGLOAD(t_)                                                      \
  {                                                                     \
    const bf16_t* a_ = kn_p + (size_t)(t_) * 32 * 1024;                 \
    rk0 = *(const uint4*)(a_);                                          \
    rk1 = *(const uint4*)(a_ + 8);                                      \
    rk2 = *(const uint4*)(kpe_p + (size_t)(t_) * 32 * 64);              \
    const bf16_t* c_ = vt_p + (t_) * 32;                                \
    rv0 = *(const uint4*)(c_);                                          \
    rv1 = *(const uint4*)(c_ + 8);                                      \
  }
#define ASTORE(buf_)                                                    \
  {                                                                     \
    bf16_t* d_ = sKb + (buf_) * 32 * 200 + krow_ * 200;                 \
    *(uint4*)(d_ + kpart * 16) = rk0;                                   \
    *(uint4*)(d_ + kpart * 16 + 8) = rk1;                               \
    *(uint4*)(d_ + 128 + kpart * 8) = rk2;                              \
    bf16_t* f_ = sVb + (buf_) * 128 * 40 + vrow * 40 + vhalf * 16;      \
    *(uint4*)(f_) = rv0;                                                \
    *(uint4*)(f_ + 8) = rv1;                                            \
  }
    const int nt32 = nkt * 2;
    AGLOAD(0);
    ASTORE(0);
    AGLOAD(1);
    for (int t = 0; t < nt32; t++) {
      __syncthreads();
      if (t + 1 < nt32) {
        ASTORE((t + 1) & 1);
        if (t + 2 < nt32) AGLOAD(t + 2);
      }
      const bf16_t* sK = sKb + (t & 1) * 32 * 200;
      const bf16_t* sV = sVb + (t & 1) * 128 * 40;
      f32x16 sv;
#pragma unroll
      for (int e = 0; e < 16; e++) sv[e] = 0.f;
#define ALDV(d_, s2_) ({ union { bf16x8 v; uint2 u[2]; } t_; const bf16_t* vp_ = vbase + (d_) * 1280 + 16 * (s2_); \
                         t_.u[0] = *(const uint2*)vp_; t_.u[1] = *(const uint2*)(vp_ + 8); t_.v; })
      const bf16_t* kp = sK + r * 200 + h * 8;
      const bf16_t* vbase = sV + r * 40 + 4 * h;
      bf16x8 kq0 = *(const bf16x8*)(kp), kq1 = *(const bf16x8*)(kp + 16), kq2 = *(const bf16x8*)(kp + 32),
             kq3 = *(const bf16x8*)(kp + 48);
#pragma unroll
      for (int kk = 0; kk < 12; kk += 4) {
        __builtin_amdgcn_sched_barrier(0);
        sv = __builtin_amdgcn_mfma_f32_32x32x16_bf16(kq0, qf[kk], sv, 0, 0, 0);
        if (kk + 4 < 12) kq0 = *(const bf16x8*)(kp + (kk + 4) * 16);
        __builtin_amdgcn_sched_barrier(0);
        sv = __builtin_amdgcn_mfma_f32_32x32x16_bf16(kq1, qf[kk + 1], sv, 0, 0, 0);
        if (kk + 4 < 12) kq1 = *(const bf16x8*)(kp + (kk + 5) * 16);
        __builtin_amdgcn_sched_barrier(0);
        sv = __builtin_amdgcn_mfma_f32_32x32x16_bf16(kq2, qf[kk + 2], sv, 0, 0, 0);
        if (kk + 4 < 12) kq2 = *(const bf16x8*)(kp + (kk + 6) * 16);
        __builtin_amdgcn_sched_barrier(0);
        sv = __builtin_amdgcn_mfma_f32_32x32x16_bf16(kq3, qf[kk + 3], sv, 0, 0, 0);
        if (kk + 4 < 12) kq3 = *(const bf16x8*)(kp + (kk + 7) * 16);
      }
      __builtin_amdgcn_sched_barrier(0);
      bf16x8 va = ALDV(0, 0), vb = ALDV(1, 0), vc = ALDV(2, 0), vd = ALDV(3, 0);
      __builtin_amdgcn_sched_barrier(0);
      float mx = sv[0];
#pragma unroll
      for (int e = 1; e < 16; e++) mx = fmaxf(mx, sv[e]);
      mx = fmaxf(mx, __shfl_xor(mx, 32));
      const float mnew = fmaxf(m, mx);
      const float alpha = __builtin_amdgcn_exp2f(m - mnew);
      m = mnew;
      if (!__all(alpha == 1.f)) {
#pragma unroll
        for (int d = 0; d < 4; d++)
#pragma unroll
          for (int e = 0; e < 16; e++) o[d][e] *= alpha;
      }
      float ps = 0.f;
      union { bf16x8 v; unsigned u[4]; } pf0, pf1;
#pragma unroll
      for (int e = 0; e < 8; e++) {
        float pv = __builtin_amdgcn_exp2f(sv[e] - mnew);
        sv[e] = pv;
        ps += pv;
      }
#pragma unroll
      for (int e = 0; e < 4; e++) pf0.u[e] = pack2(sv[2 * e], sv[2 * e + 1]);
      __builtin_amdgcn_sched_barrier(0);
      o[0] = __builtin_amdgcn_mfma_f32_32x32x16_bf16(va, pf0.v, o[0], 0, 0, 0);
      va = ALDV(0, 1);
      __builtin_amdgcn_sched_barrier(0);
      o[1] = __builtin_amdgcn_mfma_f32_32x32x16_bf16(vb, pf0.v, o[1], 0, 0, 0);
      vb = ALDV(1, 1);
      __builtin_amdgcn_sched_barrier(0);
      o[2] = __builtin_amdgcn_mfma_f32_32x32x16_bf16(vc, pf0.v, o[2], 0, 0, 0);
      vc = ALDV(2, 1);
      __builtin_amdgcn_sched_barrier(0);
      o[3] = __builtin_amdgcn_mfma_f32_32x32x16_bf16(vd, pf0.v, o[3], 0, 0, 0);
      vd = ALDV(3, 1);
      __builtin_amdgcn_sched_barrier(0);
#pragma unroll
      for (int e = 8; e < 16; e++) {
        float pv = __builtin_amdgcn_exp2f(sv[e] - mnew);
        sv[e] = pv;
        ps += pv;
      }
      l = l * alpha + ps;
#pragma unroll
      for (int e = 0; e < 4; e++) pf1.u[e] = pack2(sv[8 + 2 * e], sv[8 + 2 * e + 1]);
      __builtin_amdgcn_sched_barrier(0);
      o[0] = __builtin_amdgcn_mfma_f32_32x32x16_bf16(va, pf1.v, o[0], 0, 0, 0);
      o[1] = __builtin_amdgcn_mfma_f32_32x32x16_bf16(vb, pf1.v, o[1], 0, 0, 0);
      o[2] = __builtin_amdgcn_mfma_f32_32x32x16_bf16(vc, pf1.v, o[2], 0, 0, 0);
      o[3] = __builtin_amdgcn_mfma_f32_32x32x16_bf16(vd, pf1.v, o[3], 0, 0, 0);
    }
    __syncthreads();
    {
    l += __shfl_xor(l, 32);
    const float inv = 1.f / l;
    bf16_t* zp = ZS + (size_t)(tq0 + qh * 32 + r) * 1024 + head * 128;
#pragma unroll
    for (int d = 0; d < 4; d++)
#pragma unroll
      for (int j = 0; j < 4; j++) {
        bf16_t* ap = zp + d * 32 + h * 4 + 8 * j;
        uint2 z = *(const uint2*)ap;
        float v0 = o[d][4 * j] * inv * bflo(z.x), v1 = o[d][4 * j + 1] * inv * bfhi(z.x);
        float v2 = o[d][4 * j + 2] * inv * bflo(z.y), v3 = o[d][4 * j + 3] * inv * bfhi(z.y);
        *(uint2*)ap = make_uint2(pack2(v0, v1), pack2(v2, v3));
      }
    }
  }
  if (!heavyblk) {
    __syncthreads();
    const int nlight = 8 * (nloc - nheavy), rank = xcd + 8 * (local - nheavy);
    const int nitems = a == 0 ? 3232 : 2048;
    for (int j = rank; j < nitems; j += nlight) {
      const int i = a == 0 ? (j < 2720 ? j : 4256 + (j - 2720)) : (j < 1536 ? 2720 + j : 4768 + (j - 1536));
      const int t = i < 480 ? 480 + i : i < 672 ? 1152 + (i - 480) : i < 928 ? 1600 + (i - 672)
                                    : i < 1184 ? 2112 + (i - 928) : 2368 + (i - 1184);
      transpose_item(p, t, (float*)smem);
    }
  }
}

template <int K>
DEV void phase_outproj(const Params& p, int layer, const bf16_t* A, const bf16_t* W, char* smem) {
  const float* mod = (const float*)(p.ws + OFF_MODZ);
  const float* x0 = layer == 0 ? p.in[0] : p.out;
  const float* x1 = layer == 0 ? p.in[1] : p.out + (size_t)TC * D;
  float* xout = p.out;
  for (int j_ = blockIdx.x >> 3; j_ < 8 * 8; j_ += gridDim.x >> 3) {
    const int mt = (blockIdx.x & 7) * 8 + (j_ & 7), nt = j_ >> 3;
    const int m0 = mt * 192, n0 = nt * 128;
    auto epi = [=](f32x16(&acc)[2], int token, int wn, int lane) {
      const int r = lane & 31, h = lane >> 5;
      {
        const float* gate = mod + (layer * 3 + tok_group(token)) * 3072 + 2048 + n0 + wn * 64;
        const float* xi = (token < TC ? x0 + (size_t)token * D : x1 + (size_t)(token - TC) * D) + n0 + wn * 64;
        float* xo = xout + (size_t)token * D + n0 + wn * 64;
#pragma unroll
        for (int fi = 0; fi < 2; fi++)
#pragma unroll
          for (int j = 0; j < 4; j++) {
            int c = fi * 32 + h * 4 + 8 * j;
            float4 g = *(const float4*)(gate + c), x = *(const float4*)(xi + c);
            *(float4*)(xo + c) = make_float4(x.x + g.x * acc[fi][4 * j], x.y + g.y * acc[fi][4 * j + 1],
                                             x.z + g.z * acc[fi][4 * j + 2], x.w + g.w * acc[fi][4 * j + 3]);
          }
      }
    };
    gemm_tile_g192<K>(A + (size_t)m0 * K, K, W + (size_t)n0 * K, K, smem, m0, epi);
  }
}

DEV void phase_mlp_inproj(const Params& p, int mi, char* smem) {
  const bf16_t* H = (const bf16_t*)(p.ws + OFF_H);
  const bf16_t* W = (const bf16_t*)(p.ws + OFF_WIN_M) + (size_t)mi * 6144 * 1024;
  bf16_t* UZ = (bf16_t*)(p.ws + OFF_UZ);
  bf16_t* GVT = (bf16_t*)(p.ws + OFF_GVT);
  float* statv = (float*)(p.ws + OFF_STATV);
  for (int j_ = blockIdx.x >> 3; j_ < 12 * 48; j_ += gridDim.x >> 3) {
    const int mt = (blockIdx.x & 7) * 12 + j_ % 12, nt = j_ / 12;
    const int m0 = mt * 128, n0 = nt * 128;
    auto epi = [=](f32x16(&acc)[2], int token, int wn, int lane) {
      const int r = lane & 31, h = lane >> 5;
      {
        if (nt < 32) {
          bf16_t* dst = UZ + (size_t)token * 2048 + nt * 64 + wn * 32;
#pragma unroll
          for (int j = 0; j < 4; j++) {
            float v0 = gelu_f(acc[0][4 * j]) * silu_f(acc[1][4 * j]);
            float v1 = gelu_f(acc[0][4 * j + 1]) * silu_f(acc[1][4 * j + 1]);
            float v2 = gelu_f(acc[0][4 * j + 2]) * silu_f(acc[1][4 * j + 2]);
            float v3 = gelu_f(acc[0][4 * j + 3]) * silu_f(acc[1][4 * j + 3]);
            *(uint2*)(dst + h * 4 + 8 * j) = make_uint2(pack2(v0, v1), pack2(v2, v3));
          }
        } else {
          const int ch0 = (nt - 32) * 128 + wn * 64;
          bf16_t* dst = GVT + ((size_t)(token >> 7) * 2048 + ch0) * 128 + (token & 127);
          float s1 = 0.f, s2 = 0.f;
#pragma unroll
          for (int fi = 0; fi < 2; fi++)
#pragma unroll
            for (int e = 0; e < 16; e++) {
              float g = gelu_f(acc[fi][e]);
              s1 += g;
              s2 += g * g;
              int ch = fi * 32 + h * 4 + 8 * (e >> 2) + (e & 3);
              dst[(size_t)ch * 128] = f2bf(g);
            }
          s1 += __shfl_xor(s1, 32);
          s2 += __shfl_xor(s2, 32);
          if (h == 0) *(float2*)(statv + ((size_t)token * 32 + (nt - 32) * 2 + wn) * 2) = make_float2(s1, s2);
        }
      }
    };
    gemm_tile_g<1024>(H + (size_t)m0 * 64, 64, W + (size_t)n0 * 64, 64, smem, m0, epi, (size_t)T * 64, (size_t)6144 * 64);
  }
}

struct LnXf {
  const float* smu;
  const float* vg;
  const float* vb;
  DEV uint4 operator()(uint4 v, int row, int kc) const {
    const float g = vg[row], b = vb[row];
    const float* mu = smu + kc;
    const float* rs = smu + 128 + kc;
    float f0 = (bflo(v.x) - mu[0]) * rs[0] * g + b, f1 = (bfhi(v.x) - mu[1]) * rs[1] * g + b;
    float f2 = (bflo(v.y) - mu[2]) * rs[2] * g + b, f3 = (bfhi(v.y) - mu[3]) * rs[3] * g + b;
    float f4 = (bflo(v.z) - mu[4]) * rs[4] * g + b, f5 = (bfhi(v.z) - mu[5]) * rs[5] * g + b;
    float f6 = (bflo(v.w) - mu[6]) * rs[6] * g + b, f7 = (bfhi(v.w) - mu[7]) * rs[7] * g + b;
    return make_uint4(pack2(f0, f1), pack2(f2, f3), pack2(f4, f5), pack2(f6, f7));
  }
};

DEV void phase_mlp_spatial(const Params& p, int mi, char* smem) {
  const bf16_t* WS = (const bf16_t*)(p.ws + OFF_WS) + (size_t)mi * 8 * 128 * 128;
  const bf16_t* GVT = (const bf16_t*)(p.ws + OFF_GVT);
  bf16_t* UZ = (bf16_t*)(p.ws + OFF_UZ);
  const float* statv = (const float*)(p.ws + OFF_STATV);
  float* smu = (float*)(smem + 2 * 2 * 128 * 72 * 2);
  for (int t = blockIdx.x; t < 96 * 16; t += gridDim.x) {
    const int c = t >> 4, g = (t >> 1) & 7, hf = t & 1;
    if (threadIdx.x < 128) {
      const float* sp = statv + (size_t)(c * 128 + threadIdx.x) * 64;
      float s1 = 0.f, s2 = 0.f;
#pragma unroll
      for (int i = 0; i < 16; i++) {
        float4 v = *(const float4*)(sp + 4 * i);
        s1 += v.x + v.z;
        s2 += v.y + v.w;
      }
      float mu = s1 * (1.f / 2048.f);
      float var = s2 * (1.f / 2048.f) - mu * mu;
      smu[threadIdx.x] = mu;
      smu[128 + threadIdx.x] = rsqrtf(fmaxf(var, 0.f) + EPS);
    }
    __syncthreads();
    const int ch0 = g * 256 + hf * 128;
    LnXf xf{smu, p.in[16] + mi * 2048 + ch0, p.in[17] + mi * 2048 + ch0};
    const float* bs = p.in[19] + (mi * 8 + g) * 128;
    auto epi = [=](f32x16(&acc)[2], int token, int wn, int lane) {
      const int r = lane & 31, h = lane >> 5;
      {
        const int pt = token;
        const float b = bs[pt];
        bf16_t* dst = UZ + (size_t)(c * 128 + pt) * 2048 + ch0 + wn * 64;
#pragma unroll
        for (int fi = 0; fi < 2; fi++)
#pragma unroll
          for (int j = 0; j < 4; j++) {
            bf16_t* ap = dst + fi * 32 + h * 4 + 8 * j;
            uint2 u = *(const uint2*)ap;
            float v0 = bflo(u.x) * (acc[fi][4 * j] + b), v1 = bfhi(u.x) * (acc[fi][4 * j + 1] + b);
            float v2 = bflo(u.y) * (acc[fi][4 * j + 2] + b), v3 = bfhi(u.y) * (acc[fi][4 * j + 3] + b);
            *(uint2*)ap = make_uint2(pack2(v0, v1), pack2(v2, v3));
          }
      }
    };
    gemm_tile<128>(WS + (size_t)g * 128 * 128, 128, GVT + ((size_t)c * 2048 + ch0) * 128, 128, smem, 0, epi, xf);
  }
}

DEV void phase_final(const Params& p) {
  const int tid_ = opaque_tid(); const int lane = tid_ & 63, w = tid_ >> 6;
  const float* fg = p.in[21];
  for (int row = blockIdx.x * 4 + w; row < T; row += gridDim.x * 4) {
    float* xr = p.out + (size_t)row * D;
    float4 v[4];
    float ss = 0.f;
#pragma unroll
    for (int i = 0; i < 4; i++) {
      v[i] = *(const float4*)(xr + i * 256 + lane * 4);
      ss += v[i].x * v[i].x + v[i].y * v[i].y + v[i].z * v[i].z + v[i].w * v[i].w;
    }
    ss = wave_sum(ss);
    const float rstd = rsqrtf(ss * (1.f / 1024.f) + EPS);
#pragma unroll
    for (int i = 0; i < 4; i++) {
      int c = i * 256 + lane * 4;
      float4 g = *(const float4*)(fg + c);
      *(float4*)(xr + c) = make_float4(v[i].x * rstd * g.x, v[i].y * rstd * g.y, v[i].z * rstd * g.z, v[i].w * rstd * g.w);
    }
  }
}

#define XB_TMO      128
#define XB_XCNT(j)  (256  + 64 * (j))
#define XB_XSUB(j)  (1280 + 64 * (j))
#define XB_XGEN(j)  (2304 + 64 * (j))
#define XB_TOP      3328
#define XB_TOPGEN   3392
#define XCD_BAR_WORDS 3456
#define XB_SPIN_CAP (1u << 18)
#define LAS __attribute__((address_space(3)))

__device__ __forceinline__ unsigned xb_ld(unsigned* p)              { return __hip_atomic_load(p, __ATOMIC_RELAXED, __HIP_MEMORY_SCOPE_AGENT); }
__device__ __forceinline__ unsigned xb_add(unsigned* p, unsigned v) { return __hip_atomic_fetch_add(p, v, __ATOMIC_RELAXED, __HIP_MEMORY_SCOPE_AGENT); }
__device__ __forceinline__ unsigned xb_xcc_id() { return (unsigned)__builtin_amdgcn_s_getreg((3 << 11) | 20) & 0xFu; }
#define XB_SPIN(cond, bar) do { unsigned _sp = 0; while (cond) { __builtin_amdgcn_s_sleep(1); \
    if ((++_sp & 255u) == 0u) { if (xb_ld(&(bar)[XB_TMO])) break; if (_sp > XB_SPIN_CAP) { atomicAdd(&(bar)[XB_TMO], 1u); break; } } } } while (0)

struct XcdBarrier {
    unsigned* bar; unsigned x;
    volatile LAS unsigned* st;
};

__device__ __forceinline__ XcdBarrier xcd_barrier_post(unsigned* bar, volatile LAS unsigned* st) {
    XcdBarrier b; b.bar = bar; b.x = xb_xcc_id(); b.st = st;
    if (threadIdx.x == 0) (void)xb_add(&bar[XB_XCNT(b.x)], 1u);
    return b;
}
__device__ __forceinline__ void xcd_barrier_complete(unsigned* bar, unsigned x, unsigned& nloc, unsigned& nx) {
    const unsigned G = gridDim.x * gridDim.y * gridDim.z;
    unsigned sum, cnt, mine, sp = 0u;
    for (;;) {
        sum = 0u; cnt = 0u; mine = 0u;
#pragma unroll
        for (unsigned j = 0; j < 16; ++j) { const unsigned c = xb_ld(&bar[XB_XCNT(j)]); sum += c; cnt += (c > 0u) ? 1u : 0u; mine = (j == x) ? c : mine; }
        if (sum == G) break;
        __builtin_amdgcn_s_sleep(1);
        if ((++sp & 255u) == 0u) { if (xb_ld(&bar[XB_TMO])) break; if (sp > XB_SPIN_CAP) { atomicAdd(&bar[XB_TMO], 1u); break; } }
    }
    nloc = mine > 0u ? mine : 1u; nx = cnt > 0u ? cnt : 1u;
}

__device__ __forceinline__ void xcd_barrier(const XcdBarrier& b) {
    asm volatile("s_waitcnt vmcnt(0)" ::: "memory");
    __syncthreads();
    if (threadIdx.x == 0) {
        unsigned* bar = b.bar;
        __builtin_amdgcn_s_waitcnt(0);
        unsigned nloc = b.st[0], nx = b.st[1];
        if (nloc == 0u) { xcd_barrier_complete(bar, b.x, nloc, nx); b.st[0] = nloc; b.st[1] = nx; }
        const unsigned old = xb_add(&bar[XB_XSUB(b.x)], 1u);
        const unsigned gen = old / nloc;
        if (old + 1u == (gen + 1u) * nloc) {
            __builtin_amdgcn_fence(__ATOMIC_RELEASE, "agent");
            asm volatile("s_waitcnt vmcnt(0)" ::: "memory");
            const unsigned og = xb_add(&bar[XB_TOP], 1u);
            const unsigned tg = og / nx;
            if (og + 1u == (tg + 1u) * nx) xb_add(&bar[XB_TOPGEN], 1u);
            else XB_SPIN(xb_ld(&bar[XB_TOPGEN]) == tg, bar);
            __builtin_amdgcn_fence(__ATOMIC_ACQUIRE, "agent");
            xb_add(&bar[XB_XGEN(b.x)], 1u);
            asm volatile("s_waitcnt vmcnt(0)" ::: "memory");
        } else {
            XB_SPIN(xb_ld(&bar[XB_XGEN(b.x)]) == gen, bar);
            __builtin_amdgcn_fence(__ATOMIC_ACQUIRE, "agent");
            asm volatile("s_waitcnt vmcnt(0)" ::: "memory");
        }
    }
    __syncthreads();
}


__global__ void __launch_bounds__(256, 2) fwd_megakernel(Params p) {
  extern __shared__ __attribute__((aligned(16))) char smem[];
  cg::grid_group grid = cg::this_grid();
  volatile LAS unsigned* xb_st = (volatile LAS unsigned*)(smem + LDS_MAIN);
  if (threadIdx.x == 0) { xb_st[0] = 0u; xb_st[1] = 0u; xb_st[2] = 0u; xb_st[3] = 0u; }
  __syncthreads();
  XcdBarrier xb = xcd_barrier_post((unsigned*)(p.ws + OFF_BAR), xb_st);
  if (p.lo < 0) grid.sync();
  int pc = 0;
#define PHASE(body)                         \
  {                                         \
    if (pc >= p.lo && pc < p.hi) {          \
      body;                                 \
      if (pc + 1 < p.hi) xcd_barrier(xb);   \
    }                                       \
    pc++;                                   \
  }
  PHASE(phase_prep(p, smem));
#pragma unroll 1
  for (int layer = 0; layer < 4; layer++) {
    const int a = layer >> 1;
    PHASE(phase_prenorm(p, layer));
    if ((layer & 1) == 0) {
      PHASE(phase_attn_inproj(p, layer, a, smem));
      PHASE(phase_attn_up(p, layer, a, smem));
      PHASE(phase_attn_core(p, a, smem));
      PHASE(phase_outproj<1024>(p, layer, (const bf16_t*)(p.ws + OFF_ZS),
                          (const bf16_t*)(p.ws + OFF_WO_A) + (size_t)a * 1024 * 1024, smem));
    } else {
      PHASE(phase_mlp_inproj(p, a, smem));
      PHASE(phase_mlp_spatial(p, a, smem));
      PHASE(phase_outproj<2048>(p, layer, (const bf16_t*)(p.ws + OFF_UZ),
                          (const bf16_t*)(p.ws + OFF_WO_M) + (size_t)a * 1024 * 2048, smem));
    }
  }
  PHASE(phase_final(p));
}

extern "C" void kernel_launch(void* const* d_in, const int* in_sizes, int n_in, void* d_out, int out_size, void* d_ws,
                              size_t ws_size, hipStream_t stream) {
  static int grid_blocks = 0;
  if (!grid_blocks) {
    hipFuncSetAttribute((const void*)fwd_megakernel, hipFuncAttributeMaxDynamicSharedMemorySize, LDS_BYTES);
    int dev = 0, cus = 0, per_cu = 0;
    hipGetDevice(&dev);
    hipDeviceGetAttribute(&cus, hipDeviceAttributeMultiprocessorCount, dev);
    hipOccupancyMaxActiveBlocksPerMultiprocessor(&per_cu, fwd_megakernel, 256, LDS_BYTES);
    if (per_cu > 2) per_cu = 2;
    if (per_cu < 1) per_cu = 1;
    grid_blocks = cus * per_cu;
  }
  Params p{};
  for (int i = 0; i < 22; i++) p.in[i] = (const float*)d_in[i];
  p.out = (float*)d_out;
  p.ws = (char*)d_ws;
  p.lo = 0;
  p.hi = 1000;
  hipMemsetAsync((char*)d_ws + OFF_BAR, 0, 16384 + SZ_MOD, stream);
  void* args[] = {&p};
  hipError_t e = hipLaunchCooperativeKernel((void*)fwd_megakernel, dim3(grid_blocks), dim3(256), args, LDS_BYTES, stream);
  if (e != hipSuccess) fprintf(stderr, "cooperative launch failed: %s (grid %d)\n", hipGetErrorString(e), grid_blocks);
}
```

```cpp
#include <hip/hip_runtime.h>
#include <hip/hip_cooperative_groups.h>
#include <stdint.h>
#include <cstdio>
namespace cg = cooperative_groups;

typedef __attribute__((ext_vector_type(8))) short bf16x8;
typedef __attribute__((ext_vector_type(16))) float f32x16;
typedef unsigned short bf16_t;

#define DEV __device__ __forceinline__

constexpr int D = 1024;
constexpr int T = 12288;
constexpr int TC = 8192;
constexpr int KT = 13312;
constexpr float EPS = 1e-6f;

constexpr size_t SZ_WIN_A = (size_t)2 * 1920 * 1024 * 2;
constexpr size_t SZ_WUQ = (size_t)2 * 1536 * 512 * 2;
constexpr size_t SZ_WUKV = (size_t)2 * 2 * 2048 * 256 * 2;
constexpr size_t SZ_WO_A = (size_t)2 * 1024 * 1024 * 2;
constexpr size_t SZ_WIN_M = (size_t)2 * 6144 * 1024 * 2;
constexpr size_t SZ_WO_M = (size_t)2 * 1024 * 2048 * 2;
constexpr size_t SZ_WS = (size_t)2 * 8 * 128 * 128 * 2;
constexpr size_t SZ_MOD = (size_t)4 * 3 * 3072 * 4;
constexpr size_t SZ_H = (size_t)T * 1024 * 2;
constexpr size_t SZ_CKVK = (size_t)2 * KT * 256 * 2;
constexpr size_t SZ_KPE = (size_t)2 * KT * 64 * 2;
constexpr size_t SZ_STATQ = (size_t)T * 8 * 4;
constexpr size_t SZ_STATKV = (size_t)T * 4 * 4;
constexpr size_t SZ_STATV = (size_t)T * 32 * 2 * 4;

constexpr size_t OFF_WIN_A = 0;
constexpr size_t OFF_WUQ = OFF_WIN_A + SZ_WIN_A;
constexpr size_t OFF_WUKV = OFF_WUQ + SZ_WUQ;
constexpr size_t OFF_WO_A = OFF_WUKV + SZ_WUKV;
constexpr size_t OFF_WIN_M = OFF_WO_A + SZ_WO_A;
constexpr size_t OFF_WO_M = OFF_WIN_M + SZ_WIN_M;
constexpr size_t OFF_WS = OFF_WO_M + SZ_WO_M;
constexpr size_t OFF_MOD = OFF_WS + SZ_WS;
constexpr size_t OFF_H = OFF_MOD + SZ_MOD;
constexpr size_t OFF_CKVK = OFF_H + SZ_H;
constexpr size_t OFF_KPE = OFF_CKVK + SZ_CKVK;
constexpr size_t OFF_STATQ = OFF_KPE + SZ_KPE;
constexpr size_t OFF_STATKV = OFF_STATQ + SZ_STATQ;
constexpr size_t OFF_STATV = OFF_STATKV + SZ_STATKV;
constexpr size_t OFF_UNION = OFF_STATV + SZ_STATV;
constexpr size_t OFF_CQ = OFF_UNION;
constexpr size_t OFF_ZS = OFF_CQ + (size_t)T * 512 * 2;
constexpr size_t OFF_Q = OFF_ZS + (size_t)T * 1024 * 2;
constexpr size_t OFF_KN = OFF_Q + (size_t)T * 1536 * 2;
constexpr size_t OFF_VT = OFF_KN + (size_t)KT * 1024 * 2;
constexpr size_t OFF_UZ = OFF_UNION;
constexpr size_t OFF_GVT = OFF_UZ + (size_t)T * 2048 * 2;

constexpr size_t OFF_BAR = OFF_VT + (size_t)KT * 1024 * 2;
constexpr size_t OFF_MODZ = OFF_BAR + 16384;
constexpr size_t WS_TOTAL = OFF_MODZ + SZ_MOD;

constexpr size_t OUT_CKV = (size_t)T * 1024;
constexpr size_t OUT_KPE = OUT_CKV + (size_t)32 * 2 * 256 * 256;

constexpr int LDS_MAIN = 2 * 2 * 128 * 72 * 2 + 1024;
constexpr int LDS_BYTES = LDS_MAIN + 16;

struct Params {
  const float* in[22];
  float* out;
  char* ws;
  int lo, hi;
};

DEV int opaque_tid() { int t = threadIdx.x; asm volatile("" : "+v"(t)); return t; }
typedef __bf16 hwbf2 __attribute__((ext_vector_type(2)));
typedef float hwf2 __attribute__((ext_vector_type(2)));
DEV unsigned pack2(float a, float b) {
  hwf2 v = {a, b};
  hwbf2 r = __builtin_convertvector(v, hwbf2);
  return *(unsigned*)&r;
}
DEV unsigned short f2bf(float f) { return (unsigned short)(pack2(f, 0.f) & 0xffffu); }
DEV float bf2f(unsigned short b) { return __uint_as_float(((unsigned)b) << 16); }
DEV float bflo(unsigned u) { return __uint_as_float(u << 16); }
DEV float bfhi(unsigned u) { return __uint_as_float(u & 0xffff0000u); }
DEV float silu_f(float x) { return x * __builtin_amdgcn_rcpf(1.f + __expf(-x)); }
DEV float gelu_f(float x) {
  float u = 0.7978845608028654f * (x + 0.044715f * x * x * x);
  return x * __builtin_amdgcn_rcpf(1.f + __expf(-2.f * u));
}
DEV int tok_group(int t) { return t < TC ? 0 : 1 + ((t - TC) >> 11); }
DEV int tok_keyrow(int t) {
  if (t < TC) return t;
  int u = t - TC;
  return TC + (u >> 11) * 2560 + 512 + (u & 2047);
}
DEV float wave_sum(float v) {
  v += __shfl_xor(v, 32);
  v += __shfl_xor(v, 16);
  v += __shfl_xor(v, 8);
  v += __shfl_xor(v, 4);
  v += __shfl_xor(v, 2);
  v += __shfl_xor(v, 1);
  return v;
}
DEV const float* xrow_in(const Params& p, int layer, int t) {
  if (layer == 0) return t < TC ? p.in[0] + (size_t)t * D : p.in[1] + (size_t)(t - TC) * D;
  return p.out + (size_t)t * D;
}

struct NoXf {
  DEV uint4 operator()(uint4 v, int row, int kc) const { return v; }
};

#define GT_LOAD(S, kt_)                                                        \
  {                                                                            \
    const bf16_t* a__ = Ap + (size_t)(kt_) * ksa;                              \
    const bf16_t* w__ = Wp + (size_t)(kt_) * ksw;                              \
    S##a0 = *(const uint4*)(a__);                                              \
    S##a1 = *(const uint4*)(a__ + (size_t)32 * lda);                           \
    S##a2 = *(const uint4*)(a__ + (size_t)64 * lda);                           \
    S##a3 = *(const uint4*)(a__ + (size_t)96 * lda);                           \
    S##w0 = *(const uint4*)(w__);                                              \
    S##w1 = *(const uint4*)(w__ + (size_t)32 * ldw);                           \
    S##w2 = *(const uint4*)(w__ + (size_t)64 * ldw);                           \
    S##w3 = *(const uint4*)(w__ + (size_t)96 * ldw);                           \
  }
#define GT_STORE(S, buf_, kt_)                                              \
  {                                                                         \
    bf16_t* dA = sA + (buf_) * 128 * 72 + lrow * 72 + lkc;                  \
    bf16_t* dW = sW + (buf_) * 128 * 72 + lrow * 72 + lkc;                  \
    *(uint4*)(dA) = S##a0;                                                  \
    *(uint4*)(dA + 32 * 72) = S##a1;                                        \
    *(uint4*)(dA + 64 * 72) = S##a2;                                        \
    *(uint4*)(dA + 96 * 72) = S##a3;                                        \
    *(uint4*)(dW) = xf(S##w0, lrow, (kt_) * 64 + lkc);                      \
    *(uint4*)(dW + 32 * 72) = xf(S##w1, lrow + 32, (kt_) * 64 + lkc);       \
    *(uint4*)(dW + 64 * 72) = xf(S##w2, lrow + 64, (kt_) * 64 + lkc);       \
    *(uint4*)(dW + 96 * 72) = xf(S##w3, lrow + 96, (kt_) * 64 + lkc);       \
  }
#define GT_LDF(dst, p_) dst = *(const bf16x8*)(p_)
#define GT_MMA4(fa0, fa1, fw0, fw1)                                                      \
  acc[0][0] = __builtin_amdgcn_mfma_f32_32x32x16_bf16(fw0, fa0, acc[0][0], 0, 0, 0);     \
  acc[0][1] = __builtin_amdgcn_mfma_f32_32x32x16_bf16(fw1, fa0, acc[0][1], 0, 0, 0);     \
  acc[1][0] = __builtin_amdgcn_mfma_f32_32x32x16_bf16(fw0, fa1, acc[1][0], 0, 0, 0);     \
  acc[1][1] = __builtin_amdgcn_mfma_f32_32x32x16_bf16(fw1, fa1, acc[1][1], 0, 0, 0);
#define GT_COMPUTE(buf_)                                                                   \
  {                                                                                        \
    const bf16_t* cA = sA + (buf_) * 128 * 72 + (wm * 64 + r) * 72 + h * 8;                \
    const bf16_t* cW = sW + (buf_) * 128 * 72 + (wn * 64 + r) * 72 + h * 8;                \
    bf16x8 xa0, xa1, xw0, xw1, ya0, ya1, yw0, yw1;                                         \
    GT_LDF(xa0, cA); GT_LDF(xw0, cW); GT_LDF(xw1, cW + 32 * 72); GT_LDF(xa1, cA + 32 * 72); \
    GT_LDF(ya0, cA + 16); GT_LDF(yw0, cW + 16); GT_LDF(yw1, cW + 32 * 72 + 16); GT_LDF(ya1, cA + 32 * 72 + 16); \
    __builtin_amdgcn_sched_barrier(0);                                                     \
    GT_MMA4(xa0, xa1, xw0, xw1)                                                            \
    __builtin_amdgcn_sched_barrier(0);                                                     \
    GT_LDF(xa0, cA + 32); GT_LDF(xw0, cW + 32); GT_LDF(xw1, cW + 32 * 72 + 32); GT_LDF(xa1, cA + 32 * 72 + 32); \
    __builtin_amdgcn_sched_barrier(0);                                                     \
    GT_MMA4(ya0, ya1, yw0, yw1)                                                            \
    __builtin_amdgcn_sched_barrier(0);                                                     \
    GT_LDF(ya0, cA + 48); GT_LDF(yw0, cW + 48); GT_LDF(yw1, cW + 32 * 72 + 48); GT_LDF(ya1, cA + 32 * 72 + 48); \
    __builtin_amdgcn_sched_barrier(0);                                                     \
    GT_MMA4(xa0, xa1, xw0, xw1)                                                            \
    GT_MMA4(ya0, ya1, yw0, yw1)                                                            \
  }

template <int K, class Epi, class Xf>
DEV void gemm_tile(const bf16_t* __restrict__ A, int lda, const bf16_t* __restrict__ W, int ldw,
                   char* smem, int m0, const Epi& epi, const Xf& xf, size_t ksa = 64, size_t ksw = 64) {
  bf16_t* sA = (bf16_t*)smem;
  bf16_t* sW = sA + 2 * 128 * 72;
  const int tid = opaque_tid(), lane = tid & 63, w = tid >> 6, wm = w & 1, wn = w >> 1;
  const int r = lane & 31, h = lane >> 5;
  f32x16 acc[2][2];
#pragma unroll
  for (int a = 0; a < 2; a++)
#pragma unroll
    for (int b = 0; b < 2; b++)
#pragma unroll
      for (int e = 0; e < 16; e++) acc[a][b][e] = 0.f;
  const int lrow = tid >> 3, lkc = (tid & 7) * 8;
  const bf16_t* Ap = A + (size_t)lrow * lda + lkc;
  const bf16_t* Wp = W + (size_t)lrow * ldw + lkc;
  uint4 Pa0, Pa1, Pa2, Pa3, Pw0, Pw1, Pw2, Pw3;
  uint4 Qa0, Qa1, Qa2, Qa3, Qw0, Qw1, Qw2, Qw3;
  constexpr int nk = K >> 6;
  GT_LOAD(P, 0);
  GT_LOAD(Q, 1);
#pragma unroll 1
  for (int kt = 0; kt < nk; kt += 2) {
    GT_STORE(P, 0, kt);
    __syncthreads();
    GT_LOAD(P, (kt + 2 < nk ? kt + 2 : nk - 2));
    GT_COMPUTE(0);
    GT_STORE(Q, 1, kt + 1);
    __syncthreads();
    GT_LOAD(Q, (kt + 3 < nk ? kt + 3 : nk - 1));
    GT_COMPUTE(1);
  }
  epi(acc[0], m0 + wm * 64 + r, wn, lane);
  epi(acc[1], m0 + wm * 64 + 32 + r, wn, lane);
  __syncthreads();
}

typedef __attribute__((address_space(3))) unsigned lds_u32_t;
#define GG_ISSUE(kt_, buf_)                                                                          \
  {                                                                                                  \
    const bf16_t* a__ = Ag + (size_t)(kt_) * ksa;                                                    \
    const bf16_t* w__ = Wg + (size_t)(kt_) * ksw;                                                    \
    char* d__ = smem + (buf_) * 32768 + w * 1024 + lane * 16;                                        \
    _Pragma("unroll") for (int i_ = 0; i_ < 4; i_++) {                                               \
      __builtin_amdgcn_global_load_lds((const unsigned*)(a__ + (size_t)(32 * i_) * lda),            \
                                       (lds_u32_t*)(d__ + i_ * 4096), 16, 0, 0);                     \
      __builtin_amdgcn_global_load_lds((const unsigned*)(w__ + (size_t)(32 * i_) * ldw),            \
                                       (lds_u32_t*)(d__ + 16384 + i_ * 4096), 16, 0, 0);             \
    }                                                                                                \
  }
#define GG_LDF(dst, base_, kk_) dst = *(const bf16x8*)((base_) + ((((kk_) * 2 + h) ^ fsw) << 4))
#define GG_COMPUTE(buf_)                                                                   \
  {                                                                                        \
    const char* cA = smem + (buf_) * 32768 + (wm * 64 + r) * 128;                          \
    const char* cW = smem + (buf_) * 32768 + 16384 + (wn * 64 + r) * 128;                  \
    bf16x8 xa0, xa1, xw0, xw1, ya0, ya1, yw0, yw1;                                         \
    GG_LDF(xa0, cA, 0); GG_LDF(xw0, cW, 0); GG_LDF(xw1, cW + 4096, 0); GG_LDF(xa1, cA + 4096, 0); \
    GG_LDF(ya0, cA, 1); GG_LDF(yw0, cW, 1); GG_LDF(yw1, cW + 4096, 1); GG_LDF(ya1, cA + 4096, 1); \
    __builtin_amdgcn_sched_barrier(0);                                                     \
    GT_MMA4(xa0, xa1, xw0, xw1)                                                            \
    __builtin_amdgcn_sched_barrier(0);                                                     \
    GG_LDF(xa0, cA, 2); GG_LDF(xw0, cW, 2); GG_LDF(xw1, cW + 4096, 2); GG_LDF(xa1, cA + 4096, 2); \
    __builtin_amdgcn_sched_barrier(0);                                                     \
    GT_MMA4(ya0, ya1, yw0, yw1)                                                            \
    __builtin_amdgcn_sched_barrier(0);                                                     \
    GG_LDF(ya0, cA, 3); GG_LDF(yw0, cW, 3); GG_LDF(yw1, cW + 4096, 3); GG_LDF(ya1, cA + 4096, 3); \
    __builtin_amdgcn_sched_barrier(0);                                                     \
    GT_MMA4(xa0, xa1, xw0, xw1)                                                            \
    GT_MMA4(ya0, ya1, yw0, yw1)                                                            \
  }

template <int K, class Epi>
DEV void gemm_tile_g(const bf16_t* __restrict__ A, int lda, const bf16_t* __restrict__ W, int ldw,
                     char* smem, int m0, const Epi& epi, size_t ksa = 64, size_t ksw = 64) {
  const int tid = opaque_tid(), lane = tid & 63, w = tid >> 6, wm = w & 1, wn = w >> 1;
  const int r = lane & 31, h = lane >> 5;
  const int fsw = (r >> 1) & 7;
  f32x16 acc[2][2];
#pragma unroll
  for (int a = 0; a < 2; a++)
#pragma unroll
    for (int b = 0; b < 2; b++)
#pragma unroll
      for (int e = 0; e < 16; e++) acc[a][b][e] = 0.f;
  const int lrow8 = lane >> 3;
  const int lchunk = (lane & 7) ^ ((((w & 1) << 2) + (lrow8 >> 1)) & 7);
  const bf16_t* Ag = A + (size_t)(w * 8 + lrow8) * lda + lchunk * 8;
  const bf16_t* Wg = W + (size_t)(w * 8 + lrow8) * ldw + lchunk * 8;
  constexpr int nk = K >> 6;
  GG_ISSUE(0, 0);
#pragma unroll 1
  for (int kt = 0; kt < nk; kt += 2) {
    asm volatile("s_waitcnt vmcnt(0)" ::: "memory");
    __syncthreads();
    GG_ISSUE(kt + 1, 1);
    GG_COMPUTE(0);
    asm volatile("s_waitcnt vmcnt(0)" ::: "memory");
    __syncthreads();
    if (kt + 2 < nk) GG_ISSUE(kt + 2, 0);
    GG_COMPUTE(1);
  }
  epi(acc[0], m0 + wm * 64 + r, wn, lane);
  epi(acc[1], m0 + wm * 64 + 32 + r, wn, lane);
  __syncthreads();
}

#define G9_STAGE 20480
#define G9_ISSUE(s_, buf_)                                                                              \
  {                                                                                                     \
    const size_t ko_ = (size_t)((s_) >> 1) * ksa + ((s_) & 1) * 32;                                     \
    const size_t kw_ = (size_t)((s_) >> 1) * ksw + ((s_) & 1) * 32;                                     \
    char* d__ = smem + (buf_) * G9_STAGE + w * 1024 + lane * 16;                                        \
    _Pragma("unroll") for (int i_ = 0; i_ < 3; i_++)                                                    \
      __builtin_amdgcn_global_load_lds((const unsigned*)(Ag + (size_t)(64 * i_) * lda + ko_),          \
                                       (lds_u32_t*)(d__ + i_ * 4096), 16, 0, 0);                        \
    _Pragma("unroll") for (int i_ = 0; i_ < 2; i_++)                                                    \
      __builtin_amdgcn_global_load_lds((const unsigned*)(Wg + (size_t)(64 * i_) * ldw + kw_),          \
                                       (lds_u32_t*)(d__ + 12288 + i_ * 4096), 16, 0, 0);                \
  }

template <int K, class Epi>
DEV void gemm_tile_g192(const bf16_t* __restrict__ A, int lda, const bf16_t* __restrict__ W, int ldw,
                        char* smem, int m0, const Epi& epi, size_t ksa = 64, size_t ksw = 64) {
  const int tid = opaque_tid(), lane = tid & 63, w = tid >> 6, wm = w & 1, wn = w >> 1;
  const int r = lane & 31, h = lane >> 5;
  const int fsw = (r >> 2) & 3;
  f32x16 acc[3][2];
#pragma unroll
  for (int a = 0; a < 3; a++)
#pragma unroll
    for (int b = 0; b < 2; b++)
#pragma unroll
      for (int e = 0; e < 16; e++) acc[a][b][e] = 0.f;
  const int lrow16 = lane >> 2;
  const int lchunk = (lane & 3) ^ ((lane >> 4) & 3);
  const bf16_t* Ag = A + (size_t)(w * 16 + lrow16) * lda + lchunk * 8;
  const bf16_t* Wg = W + (size_t)(w * 16 + lrow16) * ldw + lchunk * 8;
  constexpr int nk = K >> 5;
  asm volatile("s_waitcnt vmcnt(0)" ::: "memory");
  G9_ISSUE(0, 0);
  G9_ISSUE(1, 1);
  int buf = 0;
  const int aoff = (wm * 96 + r) * 64, woff = 12288 + (wn * 64 + r) * 64;
  const int c0 = ((0 + h) ^ fsw) << 4, c1 = ((2 + h) ^ fsw) << 4;
#pragma unroll 1
  for (int s_ = 0; s_ < nk; s_++) {
    if (s_ + 1 < nk) asm volatile("s_waitcnt vmcnt(5)" ::: "memory");
    else asm volatile("s_waitcnt vmcnt(0)" ::: "memory");
    __builtin_amdgcn_s_barrier();
    asm volatile("" ::: "memory");
    if (s_ + 2 < nk) {
      const int nb = buf >= 1 ? buf - 1 : 2;
      G9_ISSUE(s_ + 2, nb);
    }
    const char* cA = smem + buf * G9_STAGE + aoff;
    const char* cW = smem + buf * G9_STAGE + woff;
    {
      bf16x8 a0 = *(const bf16x8*)(cA + c0), a1 = *(const bf16x8*)(cA + 2048 + c0), a2 = *(const bf16x8*)(cA + 4096 + c0);
      bf16x8 w0 = *(const bf16x8*)(cW + c0), w1 = *(const bf16x8*)(cW + 2048 + c0);
      bf16x8 b0 = *(const bf16x8*)(cA + c1), b1 = *(const bf16x8*)(cA + 2048 + c1), b2 = *(const bf16x8*)(cA + 4096 + c1);
      bf16x8 v0 = *(const bf16x8*)(cW + c1), v1 = *(const bf16x8*)(cW + 2048 + c1);
      __builtin_amdgcn_sched_barrier(0);
      acc[0][0] = __builtin_amdgcn_mfma_f32_32x32x16_bf16(w0, a0, acc[0][0], 0, 0, 0);
      acc[0][1] = __builtin_amdgcn_mfma_f32_32x32x16_bf16(w1, a0, acc[0][1], 0, 0, 0);
      acc[1][0] = __builtin_amdgcn_mfma_f32_32x32x16_bf16(w0, a1, acc[1][0], 0, 0, 0);
      acc[1][1] = __builtin_amdgcn_mfma_f32_32x32x16_bf16(w1, a1, acc[1][1], 0, 0, 0);
      acc[2][0] = __builtin_amdgcn_mfma_f32_32x32x16_bf16(w0, a2, acc[2][0], 0, 0, 0);
      acc[2][1] = __builtin_amdgcn_mfma_f32_32x32x16_bf16(w1, a2, acc[2][1], 0, 0, 0);
      __builtin_amdgcn_sched_barrier(0);
      acc[0][0] = __builtin_amdgcn_mfma_f32_32x32x16_bf16(v0, b0, acc[0][0], 0, 0, 0);
      acc[0][1] = __builtin_amdgcn_mfma_f32_32x32x16_bf16(v1, b0, acc[0][1], 0, 0, 0);
      acc[1][0] = __builtin_amdgcn_mfma_f32_32x32x16_bf16(v0, b1, acc[1][0], 0, 0, 0);
      acc[1][1] = __builtin_amdgcn_mfma_f32_32x32x16_bf16(v1, b1, acc[1][1], 0, 0, 0);
      acc[2][0] = __builtin_amdgcn_mfma_f32_32x32x16_bf16(v0, b2, acc[2][0], 0, 0, 0);
      acc[2][1] = __builtin_amdgcn_mfma_f32_32x32x16_bf16(v1, b2, acc[2][1], 0, 0, 0);
    }
    buf = buf == 2 ? 0 : buf + 1;
  }
#pragma unroll
  for (int ti = 0; ti < 3; ti++) epi(acc[ti], m0 + wm * 96 + ti * 32 + r, wn, lane);
  __syncthreads();
}

DEV void rope_pair(f32x16& a, int pos, int h) {
#pragma unroll
  for (int j = 0; j < 2; j++)
#pragma unroll
    for (int i = 0; i < 4; i++) {
      int f = h * 4 + 8 * j + i;
      float inv = __builtin_amdgcn_exp2f(-(float)f * 0.8304820237218406f);
      float ang = (float)pos * inv;
      float sn, cs;
      __sincosf(ang, &sn, &cs);
      float x1 = a[4 * j + i], x2 = a[4 * (j + 2) + i];
      a[4 * j + i] = x1 * cs - x2 * sn;
      a[4 * (j + 2) + i] = x1 * sn + x2 * cs;
    }
}

DEV int perm_src(int mode, int np) {
  if (mode == 0) {
    if (np < 768) return np;
    if (np < 1792) return np + 64;
    if (np < 1856) return np - 1024;
    return -1;
  } else if (mode == 1) {
    if (np < 4096) {
      int c = np >> 6, rr = np & 63;
      return rr < 32 ? 32 * c + rr : 4096 + 32 * c + (rr - 32);
    }
    return 2048 + (np - 4096);
  }
  return np;
}

DEV void transpose_tile(const float* __restrict__ src, int N, bf16_t* __restrict__ dst, int K, int np0, int k0,
                        int mode, const float* __restrict__ kscale, float* tile, int tm_rows = 0) {
  const int tid = opaque_tid();
  const int tx = tid & 63, ty = tid >> 6;
  const int ns = perm_src(mode, np0 + tx);
  const float vmask = ns >= 0 ? 1.f : 0.f;
  const float* sp = src + (size_t)(k0 + ty) * N + (ns >= 0 ? ns : 0);
  float tv[16];
#pragma unroll
  for (int i = 0; i < 16; i++) tv[i] = sp[(size_t)(4 * i) * N];
  if (kscale) {
    float ks[16];
#pragma unroll
    for (int i = 0; i < 16; i++) ks[i] = kscale[k0 + ty + 4 * i];
#pragma unroll
    for (int i = 0; i < 16; i++) tv[i] *= ks[i];
  }
#pragma unroll
  for (int i = 0; i < 16; i++) tile[(ty + 4 * i) * 65 + tx] = tv[i] * vmask;
  __syncthreads();
  const int rr = tid >> 2, seg = tid & 3;
  unsigned o[8];
#pragma unroll
  for (int e = 0; e < 8; e++) {
    float a = tile[(seg * 16 + 2 * e) * 65 + rr];
    float b = tile[(seg * 16 + 2 * e + 1) * 65 + rr];
    o[e] = pack2(a, b);
  }
  uint4* dp = tm_rows ? (uint4*)(dst + ((size_t)(k0 >> 6) * tm_rows + np0 + rr) * 64 + seg * 16)
                      : (uint4*)(dst + (size_t)(np0 + rr) * K + k0 + seg * 16);
  dp[0] = make_uint4(o[0], o[1], o[2], o[3]);
  dp[1] = make_uint4(o[4], o[5], o[6], o[7]);
  __syncthreads();
}

DEV void transpose_item(const Params& p, int t, float* fl) {
  if (t < 960) {
    int l = t / 480, q = t % 480, nt = q / 16, kt = q % 16;
    transpose_tile(p.in[9] + (size_t)l * 1024 * 1856, 1856, (bf16_t*)(p.ws + OFF_WIN_A) + (size_t)l * 1920 * 1024,
                   1024, nt * 64, kt * 64, 0, nullptr, fl, 1920);
  } else if (t < 960 + 384) {
    t -= 960;
    int l = t / 192, q = t % 192, nt = q / 8, kt = q % 8;
    transpose_tile(p.in[12] + (size_t)l * 512 * 1536, 1536, (bf16_t*)(p.ws + OFF_WUQ) + (size_t)l * 1536 * 512, 512,
                   nt * 64, kt * 64, 2, p.in[10] + l * 512, fl);
  } else if (t < 960 + 384 + 512) {
    t -= 960 + 384;
    int lv = t / 128, q = t % 128, nt = q / 4, kt = q % 4;
    int l = lv >> 1, ver = lv & 1;
    transpose_tile(p.in[13] + (size_t)l * 256 * 2048, 2048, (bf16_t*)(p.ws + OFF_WUKV) + (size_t)lv * 2048 * 256, 256,
                   nt * 64, kt * 64, 2, ver == 0 ? p.in[11] + l * 256 : nullptr, fl);
  } else if (t < 960 + 384 + 512 + 512) {
    t -= 960 + 384 + 512;
    int l = t / 256, q = t % 256, nt = q / 16, kt = q % 16;
    transpose_tile(p.in[14] + (size_t)l * 1024 * 1024, 1024, (bf16_t*)(p.ws + OFF_WO_A) + (size_t)l * 1024 * 1024,
                   1024, nt * 64, kt * 64, 2, nullptr, fl);
  } else if (t < 960 + 384 + 512 + 512 + 3072) {
    t -= 960 + 384 + 512 + 512;
    int l = t / 1536, q = t % 1536, nt = q / 16, kt = q % 16;
    transpose_tile(p.in[15] + (size_t)l * 1024 * 6144, 6144, (bf16_t*)(p.ws + OFF_WIN_M) + (size_t)l * 6144 * 1024,
                   1024, nt * 64, kt * 64, 1, nullptr, fl, 6144);
  } else {
    t -= 960 + 384 + 512 + 512 + 3072;
    int l = t / 512, q = t % 512, nt = q / 32, kt = q % 32;
    transpose_tile(p.in[20] + (size_t)l * 2048 * 1024, 1024, (bf16_t*)(p.ws + OFF_WO_M) + (size_t)l * 1024 * 2048,
                   2048, nt * 64, kt * 64, 2, nullptr, fl);
  }
}

DEV void phase_prep(const Params& p, char* smem) {
  float* fl = (float*)smem;
  const int tid = opaque_tid(), lane = tid & 63, w = tid >> 6;
  constexpr int N_MOD = 384, N_TR = 1184, N_WS = 128, N_CKV = 256, N_KPE = 64;
  constexpr int N_ALL = N_MOD + N_TR + N_WS + N_CKV + N_KPE;
  for (int it = blockIdx.x; it < N_ALL; it += gridDim.x) {
    if (it < N_MOD) {
      const int l = it / 96, ch = (it % 96) >> 2, kq = it & 3;
      float* sc = fl;
      float* red = fl + 3072;
      for (int i = tid; i < 3072; i += 256) {
        int g = i >> 10, k = i & 1023;
        float cv = g == 0 ? p.in[5][k] : p.in[4][(g - 1) * 1024 + k];
        sc[i] = silu_f(cv);
      }
      __syncthreads();
      const float* wm_ = p.in[7] + (size_t)l * 1024 * 3072 + ch * 128 + lane * 2;
      float a0[3] = {0.f, 0.f, 0.f}, a1[3] = {0.f, 0.f, 0.f};
#pragma unroll 16
      for (int k = kq * 256 + w * 64; k < kq * 256 + w * 64 + 64; k++) {
        float2 wv = *(const float2*)(wm_ + (size_t)k * 3072);
#pragma unroll
        for (int g = 0; g < 3; g++) {
          float s = sc[g * 1024 + k];
          a0[g] += s * wv.x;
          a1[g] += s * wv.y;
        }
      }
#pragma unroll
      for (int g = 0; g < 3; g++) {
        red[(w * 3 + g) * 128 + lane * 2] = a0[g];
        red[(w * 3 + g) * 128 + lane * 2 + 1] = a1[g];
      }
      __syncthreads();
      for (int i = tid; i < 384; i += 256) {
        int g = i >> 7, c = i & 127;
        float s = red[(0 * 3 + g) * 128 + c] + red[(1 * 3 + g) * 128 + c] + red[(2 * 3 + g) * 128 + c] +
                  red[(3 * 3 + g) * 128 + c];
        int n = ch * 128 + c;
        atomicAdd(&((float*)(p.ws + OFF_MODZ))[(l * 3 + g) * 3072 + n], s + (kq == 0 ? p.in[8][l * 3072 + n] : 0.f));
      }
      __syncthreads();
    } else if (it < N_MOD + N_TR) {
      const int i = it - N_MOD;
      const int t = i < 480 ? i : i < 672 ? 960 + (i - 480) : i < 928 ? 1344 + (i - 672) : 1856 + (i - 928);
      transpose_item(p, t, fl);
    } else {
      int t = it - N_MOD - N_TR;
      const float* src;
      bf16_t* dst;
      if (t < N_WS) {
        size_t e = (size_t)t * 2048 + tid * 8;
        src = p.in[18] + e;
        dst = (bf16_t*)(p.ws + OFF_WS) + e;
      } else if (t < N_WS + N_CKV) {
        t -= N_WS;
        size_t e = (size_t)t * 2048 + tid * 8;
        int col = e & 255;
        int rowi = (int)(e >> 8);
        int pp = rowi & 511, la = rowi >> 9, a = la & 1, lb = la >> 1;
        src = p.in[2] + e;
        dst = (bf16_t*)(p.ws + OFF_CKVK) + ((size_t)a * KT + TC + lb * 2560 + pp) * 256 + col;
      } else {
        t -= N_WS + N_CKV;
        size_t e = (size_t)t * 2048 + tid * 8;
        int col = e & 63;
        int rowi = (int)(e >> 6);
        int pp = rowi & 511, la = rowi >> 9, a = la & 1, lb = la >> 1;
        src = p.in[3] + e;
        dst = (bf16_t*)(p.ws + OFF_KPE) + ((size_t)a * KT + TC + lb * 2560 + pp) * 64 + col;
      }
      float4 v0 = *(const float4*)src, v1 = *(const float4*)(src + 4);
      *(uint4*)dst = make_uint4(pack2(v0.x, v0.y), pack2(v0.z, v0.w), pack2(v1.x, v1.y), pack2(v1.z, v1.w));
    }
  }
}

DEV void phase_prenorm(const Params& p, int layer) {
  const int tid_ = opaque_tid(); const int lane = tid_ & 63, w = tid_ >> 6;
  bf16_t* H = (bf16_t*)(p.ws + OFF_H);
  const float* mod = (const float*)(p.ws + OFF_MODZ);
  const float* ng = p.in[6] + layer * 1024;
  for (int row = blockIdx.x * 4 + w; row < T; row += gridDim.x * 4) {
    const float* xr = xrow_in(p, layer, row);
    float4 v[4];
    float ss = 0.f;
#pragma unroll
    for (int i = 0; i < 4; i++) {
      v[i] = *(const float4*)(xr + i * 256 + lane * 4);
      ss += v[i].x * v[i].x + v[i].y * v[i].y + v[i].z * v[i].z + v[i].w * v[i].w;
    }
    ss = wave_sum(ss);
    const float rstd = rsqrtf(ss * (1.f / 1024.f) + EPS);
    const float* sh = mod + (layer * 3 + tok_group(row)) * 3072;
    const float* sc = sh + 1024;
#pragma unroll
    for (int i = 0; i < 4; i++) {
      int c = i * 256 + lane * 4;
      float4 g = *(const float4*)(ng + c), s = *(const float4*)(sc + c), b = *(const float4*)(sh + c);
      float o0 = v[i].x * rstd * g.x * (1.f + s.x) + b.x;
      float o1 = v[i].y * rstd * g.y * (1.f + s.y) + b.y;
      float o2 = v[i].z * rstd * g.z * (1.f + s.z) + b.z;
      float o3 = v[i].w * rstd * g.w * (1.f + s.w) + b.w;
      *(uint2*)(H + ((size_t)(c >> 6) * T + row) * 64 + (c & 63)) = make_uint2(pack2(o0, o1), pack2(o2, o3));
    }
  }
}

DEV void phase_attn_inproj(const Params& p, int layer, int a, char* smem) {
  const bf16_t* H = (const bf16_t*)(p.ws + OFF_H);
  const bf16_t* W = (const bf16_t*)(p.ws + OFF_WIN_A) + (size_t)a * 1920 * 1024;
  bf16_t* CQ = (bf16_t*)(p.ws + OFF_CQ);
  bf16_t* ZS = (bf16_t*)(p.ws + OFF_ZS);
  bf16_t* CKVK = (bf16_t*)(p.ws + OFF_CKVK) + (size_t)a * KT * 256;
  bf16_t* KPE = (bf16_t*)(p.ws + OFF_KPE) + (size_t)a * KT * 64;
  float* statq = (float*)(p.ws + OFF_STATQ);
  float* statkv = (float*)(p.ws + OFF_STATKV);
  float* out_kpe = p.out + OUT_KPE;
  for (int j_ = blockIdx.x >> 3; j_ < 12 * 15; j_ += gridDim.x >> 3) {
    const int mt = (blockIdx.x & 7) * 12 + j_ % 12, nt = j_ / 12;
    const int m0 = mt * 128, n0 = nt * 128;
    auto epi = [=](f32x16(&acc)[2], int token, int wn, int lane) {
      const int r = lane & 31, h = lane >> 5;
      {
        if (nt < 6) {
          float ss = 0.f;
          bf16_t* dst = nt < 4 ? CQ + (size_t)token * 512 + n0 + wn * 64
                               : CKVK + (size_t)tok_keyrow(token) * 256 + (n0 - 512) + wn * 64;
#pragma unroll
          for (int fi = 0; fi < 2; fi++)
#pragma unroll
            for (int j = 0; j < 4; j++) {
              float v0 = acc[fi][4 * j], v1 = acc[fi][4 * j + 1], v2 = acc[fi][4 * j + 2],
                    v3 = acc[fi][4 * j + 3];
              ss += v0 * v0 + v1 * v1 + v2 * v2 + v3 * v3;
              *(uint2*)(dst + fi * 32 + h * 4 + 8 * j) = make_uint2(pack2(v0, v1), pack2(v2, v3));
            }
          ss += __shfl_xor(ss, 32);
          if (h == 0) {
            if (nt < 4) statq[token * 8 + nt * 2 + wn] = ss;
            else statkv[token * 4 + (nt - 4) * 2 + wn] = ss;
          }
        } else if (nt < 14) {
          bf16_t* dst = ZS + (size_t)token * 1024 + (n0 - 768) + wn * 64;
#pragma unroll
          for (int fi = 0; fi < 2; fi++)
#pragma unroll
            for (int j = 0; j < 4; j++) {
              float v0 = silu_f(acc[fi][4 * j]), v1 = silu_f(acc[fi][4 * j + 1]),
                    v2 = silu_f(acc[fi][4 * j + 2]), v3 = silu_f(acc[fi][4 * j + 3]);
              *(uint2*)(dst + fi * 32 + h * 4 + 8 * j) = make_uint2(pack2(v0, v1), pack2(v2, v3));
            }
        } else if (wn == 0) {
          if (token < TC) {
            float* od = out_kpe + ((size_t)((token >> 8) * 2 + a) * 256 + (token & 255)) * 64;
#pragma unroll
            for (int fi = 0; fi < 2; fi++)
#pragma unroll
              for (int j = 0; j < 4; j++)
                *(float4*)(od + fi * 32 + h * 4 + 8 * j) =
                    make_float4(acc[fi][4 * j], acc[fi][4 * j + 1], acc[fi][4 * j + 2], acc[fi][4 * j + 3]);
          } else {
            int s = (token - TC) & 2047;
            rope_pair(acc[0], s >> 6, h);
            rope_pair(acc[1], s & 63, h);
          }
          bf16_t* dst = KPE + (size_t)tok_keyrow(token) * 64;
#pragma unroll
          for (int fi = 0; fi < 2; fi++)
#pragma unroll
            for (int j = 0; j < 4; j++)
              *(uint2*)(dst + fi * 32 + h * 4 + 8 * j) =
                  make_uint2(pack2(acc[fi][4 * j], acc[fi][4 * j + 1]), pack2(acc[fi][4 * j + 2], acc[fi][4 * j + 3]));
        }
      }
    };
    gemm_tile_g<1024>(H + (size_t)m0 * 64, 64, W + (size_t)n0 * 64, 64, smem, m0, epi, (size_t)T * 64, (size_t)1920 * 64);
  }
}

DEV void phase_attn_up(const Params& p, int layer, int a, char* smem) {
  const bf16_t* CQ = (const bf16_t*)(p.ws + OFF_CQ);
  const bf16_t* WUQ = (const bf16_t*)(p.ws + OFF_WUQ) + (size_t)a * 1536 * 512;
  const bf16_t* CKVK = (const bf16_t*)(p.ws + OFF_CKVK) + (size_t)a * KT * 256;
  bf16_t* Q = (bf16_t*)(p.ws + OFF_Q);
  bf16_t* KN = (bf16_t*)(p.ws + OFF_KN);
  bf16_t* VT = (bf16_t*)(p.ws + OFF_VT);
  const float* statq = (const float*)(p.ws + OFF_STATQ);
  const float* statkv = (const float*)(p.ws + OFF_STATKV);
  constexpr int NQ = 96 * 12, NKV = 104 * 16, NCK = 128;
  const float qscale = 0.07216878364870322f * 1.4426950408889634f;
  const int xcd_ = blockIdx.x & 7;
  for (int t = blockIdx.x >> 3; t < (NQ + NKV + NCK) / 8; t += gridDim.x >> 3) {
    if (t < NQ / 8) {
      const int mt = xcd_ * 12 + t % 12, nt = t / 12;
      const int m0 = mt * 128, n0 = nt * 128;
      auto epi = [=](f32x16(&acc)[2], int token, int wn, int lane) {
        const int r = lane & 31, h = lane >> 5;
        const int b64 = (n0 + wn * 64) >> 6;
        const bool ropeblk = (b64 % 3) == 2;
        {
          const float4 s0 = *(const float4*)(statq + token * 8), s1 = *(const float4*)(statq + token * 8 + 4);
          const float ss = s0.x + s0.y + s0.z + s0.w + s1.x + s1.y + s1.z + s1.w;
          const float sc = rsqrtf(ss * (1.f / 512.f) + EPS) * qscale;
#pragma unroll
          for (int fi = 0; fi < 2; fi++)
#pragma unroll
            for (int e = 0; e < 16; e++) acc[fi][e] *= sc;
          if (ropeblk && token >= TC) {
            int s = (token - TC) & 2047;
            rope_pair(acc[0], s >> 6, h);
            rope_pair(acc[1], s & 63, h);
          }
          bf16_t* dst = Q + (size_t)token * 1536 + n0 + wn * 64;
#pragma unroll
          for (int fi = 0; fi < 2; fi++)
#pragma unroll
            for (int j = 0; j < 4; j++)
              *(uint2*)(dst + fi * 32 + h * 4 + 8 * j) =
                  make_uint2(pack2(acc[fi][4 * j], acc[fi][4 * j + 1]), pack2(acc[fi][4 * j + 2], acc[fi][4 * j + 3]));
        }
      };
      gemm_tile_g<512>(CQ + (size_t)m0 * 512, 512, WUQ + (size_t)n0 * 512, 512, smem, m0, epi);
    } else if (t < (NQ + NKV) / 8) {
      const int tt = t - NQ / 8;
      const int mt = xcd_ * 13 + tt % 13, nt = tt / 13;
      const int m0 = mt * 128, n0 = nt * 128;
      const bool isCache = (m0 >= TC) && (((m0 - TC) % 2560) < 512);
      const bf16_t* WUKV = (const bf16_t*)(p.ws + OFF_WUKV) + (size_t)(a * 2 + (isCache ? 1 : 0)) * 2048 * 256;
      const int head = nt >> 1;
      auto epi = [=](f32x16(&acc)[2], int token, int wn, int lane) {
        const int r = lane & 31, h = lane >> 5;
        {
          const int krow = token;
          float sc = 1.f;
          if (!isCache) {
            int token = krow;
            if (krow >= TC) {
              int u = krow - TC;
              int lb = u / 2560;
              token = TC + lb * 2048 + (u - lb * 2560 - 512);
            }
            const float4 s0 = *(const float4*)(statkv + token * 4);
            sc = rsqrtf((s0.x + s0.y + s0.z + s0.w) * (1.f / 256.f) + EPS);
          }
          if ((nt & 1) == 0) {
            bf16_t* dst = KN + (size_t)krow * 1024 + head * 128 + wn * 64;
#pragma unroll
            for (int fi = 0; fi < 2; fi++)
#pragma unroll
              for (int j = 0; j < 4; j++)
                *(uint2*)(dst + fi * 32 + h * 4 + 8 * j) =
                    make_uint2(pack2(acc[fi][4 * j] * sc, acc[fi][4 * j + 1] * sc),
                               pack2(acc[fi][4 * j + 2] * sc, acc[fi][4 * j + 3] * sc));
          } else {
            bf16_t* dst = VT + (size_t)(head * 128 + wn * 64) * KT + krow;
#pragma unroll
            for (int fi = 0; fi < 2; fi++)
#pragma unroll
              for (int e = 0; e < 16; e++) {
                int dv = fi * 32 + h * 4 + 8 * (e >> 2) + (e & 3);
                dst[(size_t)dv * KT] = f2bf(acc[fi][e] * sc);
              }
          }
        }
      };
      gemm_tile_g<256>(CKVK + (size_t)m0 * 256, 256, WUKV + (size_t)n0 * 256, 256, smem, m0, epi);
    } else {
      const int tt = xcd_ * 16 + (t - (NQ + NKV) / 8);
      const float* gk = p.in[11] + a * 256;
      float* oc = p.out + OUT_CKV;
      for (int i = threadIdx.x; i < 64 * 32; i += 256) {
        int token = tt * 64 + (i >> 5), c = (i & 31) * 8;
        const float4 s0 = *(const float4*)(statkv + token * 4);
        const float sc = rsqrtf((s0.x + s0.y + s0.z + s0.w) * (1.f / 256.f) + EPS);
        uint4 v = *(const uint4*)(CKVK + (size_t)token * 256 + c);
        float4 g0 = *(const float4*)(gk + c), g1 = *(const float4*)(gk + c + 4);
        float* od = oc + ((size_t)((token >> 8) * 2 + a) * 256 + (token & 255)) * 256 + c;
        *(float4*)od = make_float4(bflo(v.x) * sc * g0.x, bfhi(v.x) * sc * g0.y, bflo(v.y) * sc * g0.z, bfhi(v.y) * sc * g0.w);
        *(float4*)(od + 4) = make_float4(bflo(v.z) * sc * g1.x, bfhi(v.z) * sc * g1.y, bflo(v.w) * sc * g1.z, bfhi(v.w) * sc * g1.w);
      }
    }
  }
}

DEV void phase_attn_core(const Params& p, int a, char* smem) {
  const bf16_t* Q = (const bf16_t*)(p.ws + OFF_Q);
  const bf16_t* KN = (const bf16_t*)(p.ws + OFF_KN);
  const bf16_t* VT = (const bf16_t*)(p.ws + OFF_VT);
  const bf16_t* KPE = (const bf16_t*)(p.ws + OFF_KPE) + (size_t)a * KT * 64;
  bf16_t* ZS = (bf16_t*)(p.ws + OFF_ZS);
  bf16_t* sK = (bf16_t*)smem;
  bf16_t* sV = sK + 64 * 200;
  const int tid = opaque_tid(), lane = tid & 63, w = tid >> 6, r = lane & 31, h = lane >> 5;
  const int qh = w;
  const int xcd = blockIdx.x & 7, nloc = gridDim.x >> 3, local = blockIdx.x >> 3, nheavy = nloc >> 1;
  const bool heavyblk = local < nheavy;
  const int istart = heavyblk ? local : local - nheavy;
  const int istep = heavyblk ? nheavy : nloc - nheavy;
  const int iend = heavyblk ? 32 : 64;
  for (int item = istart; item < iend; item += istep) {
    int head, tq0, kr0, nkt;
    if (heavyblk) {
      int pair = xcd * 2 + (item >> 4);
      int lb = pair >> 3;
      head = pair & 7;
      tq0 = TC + lb * 2048 + (item & 15) * 128;
      kr0 = TC + lb * 2560;
      nkt = 40;
    } else {
      int pair = xcd * 32 + (item >> 1);
      int b = pair >> 3;
      head = pair & 7;
      tq0 = b * 256 + (item & 1) * 128;
      kr0 = b * 256;
      nkt = 4;
    }
    bf16x8 qf[12];
    {
      const bf16_t* qp = Q + (size_t)(tq0 + qh * 32 + r) * 1536 + head * 192 + h * 8;
#pragma unroll
      for (int kk = 0; kk < 12; kk++) qf[kk] = *(const bf16x8*)(qp + kk * 16);
    }
    f32x16 o[4];
#pragma unroll
    for (int d = 0; d < 4; d++)
#pragma unroll
      for (int e = 0; e < 16; e++) o[d][e] = 0.f;
    float m = -1e30f, l = 0.f;
    uint4 rk0, rk1, rk2, rv0, rv1;
    const int krow_ = tid >> 3, kpart = tid & 7, vrow = tid >> 1, vhalf = tid & 1;
    const bf16_t* kn_p = KN + (size_t)(kr0 + krow_) * 1024 + head * 128 + kpart * 16;
    const bf16_t* kpe_p = KPE + (size_t)(kr0 + krow_) * 64 + kpart * 8;
    const bf16_t* vt_p = VT + (size_t)(head * 128 + vrow) * KT + kr0 + vhalf * 16;
    bf16_t* sKb = (bf16_t*)smem;
    bf16_t* sVb = sKb + 2 * 32 * 200;
#define AGLOAD(t_)                                                      \
  {                                                                     \
    const bf16_t* a_ = kn_p + (size_t)(t_) * 32 * 1024;                 \
    rk0 = *(const uint4*)(a_);                                          \
    rk1 = *(const uint4*)(a_ + 8);                                      \
    rk2 = *(const uint4*)(kpe_p + (size_t)(t_) * 32 * 64);              \
    const bf16_t* c_ = vt_p + (t_) * 32;                                \
    rv0 = *(const uint4*)(c_);                                          \
    rv1 = *(const uint4*)(c_ + 8);                                      \
  }
#define ASTORE(buf_)                                                    \
  {                                                                     \
    bf16_t* d_ = sKb + (buf_) * 32 * 200 + krow_ * 200;                 \
    *(uint4*)(d_ + kpart * 16) = rk0;                                   \
    *(uint4*)(d_ + kpart * 16 + 8) = rk1;                               \
    *(uint4*)(d_ + 128 + kpart * 8) = rk2;                              \
    bf16_t* f_ = sVb + (buf_) * 128 * 40 + vrow * 40 + vhalf * 16;      \
    *(uint4*)(f_) = rv0;                                                \
    *(uint4*)(f_ + 8) = rv1;                                            \
  }
    const int nt32 = nkt * 2;
    AGLOAD(0);
    ASTORE(0);
    AGLOAD(1);
    for (int t = 0; t < nt32; t++) {
      __syncthreads();
      const bf16_t* sK = sKb + (t & 1) * 32 * 200;
      const bf16_t* sV = sVb + (t & 1) * 128 * 40;
      f32x16 sv;
#pragma unroll
      for (int e = 0; e < 16; e++) sv[e] = 0.f;
#define ALDV(d_, s2_) ({ union { bf16x8 v; uint2 u[2]; } t_; const bf16_t* vp_ = vbase + (d_) * 1280 + 16 * (s2_); \
                         t_.u[0] = *(const uint2*)vp_; t_.u[1] = *(const uint2*)(vp_ + 8); t_.v; })
      const bf16_t* kp = sK + r * 200 + h * 8;
      const bf16_t* vbase = sV + r * 40 + 4 * h;
      bf16x8 kq0 = *(const bf16x8*)(kp), kq1 = *(const bf16x8*)(kp + 16), kq2 = *(const bf16x8*)(kp + 32),
             kq3 = *(const bf16x8*)(kp + 48);
      __builtin_amdgcn_sched_barrier(0);
      if (t + 1 < nt32) {
        ASTORE((t + 1) & 1);
        if (t + 2 < nt32) AGLOAD(t + 2);
      }
#pragma unroll
      for (int kk = 0; kk < 12; kk += 4) {
        __builtin_amdgcn_sched_barrier(0);
        sv = __builtin_amdgcn_mfma_f32_32x32x16_bf16(kq0, qf[kk], sv, 0, 0, 0);
        if (kk + 4 < 12) kq0 = *(const bf16x8*)(kp + (kk + 4) * 16);
        __builtin_amdgcn_sched_barrier(0);
        sv = __builtin_amdgcn_mfma_f32_32x32x16_bf16(kq1, qf[kk + 1], sv, 0, 0, 0);
        if (kk + 4 < 12) kq1 = *(const bf16x8*)(kp + (kk + 5) * 16);
        __builtin_amdgcn_sched_barrier(0);
        sv = __builtin_amdgcn_mfma_f32_32x32x16_bf16(kq2, qf[kk + 2], sv, 0, 0, 0);
        if (kk + 4 < 12) kq2 = *(const bf16x8*)(kp + (kk + 6) * 16);
        __builtin_amdgcn_sched_barrier(0);
        sv = __builtin_amdgcn_mfma_f32_32x32x16_bf16(kq3, qf[kk + 3], sv, 0, 0, 0);
        if (kk + 4 < 12) kq3 = *(const bf16x8*)(kp + (kk + 7) * 16);
      }
      __builtin_amdgcn_sched_barrier(0);
      bf16x8 va = ALDV(0, 0), vb = ALDV(1, 0), vc = ALDV(2, 0), vd = ALDV(3, 0);
      __builtin_amdgcn_sched_barrier(0);
      float mx = sv[0];
#pragma unroll
      for (int e = 1; e < 16; e++) mx = fmaxf(mx, sv[e]);
      mx = fmaxf(mx, __shfl_xor(mx, 32));
      const float mnew = fmaxf(m, mx);
      const float alpha = __builtin_amdgcn_exp2f(m - mnew);
      m = mnew;
      if (!__all(alpha == 1.f)) {
#pragma unroll
        for (int d = 0; d < 4; d++)
#pragma unroll
          for (int e = 0; e < 16; e++) o[d][e] *= alpha;
      }
      float ps = 0.f;
      union { bf16x8 v; unsigned u[4]; } pf0, pf1;
#pragma unroll
      for (int e = 0; e < 8; e++) {
        float pv = __builtin_amdgcn_exp2f(sv[e] - mnew);
        sv[e] = pv;
        ps += pv;
      }
#pragma unroll
      for (int e = 0; e < 4; e++) pf0.u[e] = pack2(sv[2 * e], sv[2 * e + 1]);
      __builtin_amdgcn_sched_barrier(0);
      o[0] = __builtin_amdgcn_mfma_f32_32x32x16_bf16(va, pf0.v, o[0], 0, 0, 0);
      va = ALDV(0, 1);
      __builtin_amdgcn_sched_barrier(0);
      o[1] = __builtin_amdgcn_mfma_f32_32x32x16_bf16(vb, pf0.v, o[1], 0, 0, 0);
      vb = ALDV(1, 1);
      __builtin_amdgcn_sched_barrier(0);
      o[2] = __builtin_amdgcn_mfma_f32_32x32x16_bf16(vc, pf0.v, o[2], 0, 0, 0);
      vc = ALDV(2, 1);
      __builtin_amdgcn_sched_barrier(0);
      o[3] = __builtin_amdgcn_mfma_f32_32x32x16_bf16(vd, pf0.v, o[3], 0, 0, 0);
      vd = ALDV(3, 1);
      __builtin_amdgcn_sched_barrier(0);
#pragma unroll
      for (int e = 8; e < 16; e++) {
        float pv = __builtin_amdgcn_exp2f(sv[e] - mnew);
        sv[e] = pv;
        ps += pv;
      }
      l = l * alpha + ps;
#pragma unroll
      for (int e = 0; e < 4; e++) pf1.u[e] = pack2(sv[8 + 2 * e], sv[8 + 2 * e + 1]);
      __builtin_amdgcn_sched_barrier(0);
      o[0] = __builtin_amdgcn_mfma_f32_32x32x16_bf16(va, pf1.v, o[0], 0, 0, 0);
      o[1] = __builtin_amdgcn_mfma_f32_32x32x16_bf16(vb, pf1.v, o[1], 0, 0, 0);
      o[2] = __builtin_amdgcn_mfma_f32_32x32x16_bf16(vc, pf1.v, o[2], 0, 0, 0);
      o[3] = __builtin_amdgcn_mfma_f32_32x32x16_bf16(vd, pf1.v, o[3], 0, 0, 0);
    }
    __syncthreads();
    {
    l += __shfl_xor(l, 32);
    const float inv = 1.f / l;
    bf16_t* zp = ZS + (size_t)(tq0 + qh * 32 + r) * 1024 + head * 128;
#pragma unroll
    for (int d = 0; d < 4; d++)
#pragma unroll
      for (int j = 0; j < 4; j++) {
        bf16_t* ap = zp + d * 32 + h * 4 + 8 * j;
        uint2 z = *(const uint2*)ap;
        float v0 = o[d][4 * j] * inv * bflo(z.x), v1 = o[d][4 * j + 1] * inv * bfhi(z.x);
        float v2 = o[d][4 * j + 2] * inv * bflo(z.y), v3 = o[d][4 * j + 3] * inv * bfhi(z.y);
        *(uint2*)ap = make_uint2(pack2(v0, v1), pack2(v2, v3));
      }
    }
  }
  if (!heavyblk) {
    __syncthreads();
    const int nlight = 8 * (nloc - nheavy), rank = xcd + 8 * (local - nheavy);
    const int nitems = a == 0 ? 3232 : 2048;
    for (int j = rank; j < nitems; j += nlight) {
      const int i = a == 0 ? (j < 2720 ? j : 4256 + (j - 2720)) : (j < 1536 ? 2720 + j : 4768 + (j - 1536));
      const int t = i < 480 ? 480 + i : i < 672 ? 1152 + (i - 480) : i < 928 ? 1600 + (i - 672)
                                    : i < 1184 ? 2112 + (i - 928) : 2368 + (i - 1184);
      transpose_item(p, t, (float*)smem);
    }
  }
}

template <int K>
DEV void phase_outproj(const Params& p, int layer, const bf16_t* A, const bf16_t* W, char* smem) {
  const float* mod = (const float*)(p.ws + OFF_MODZ);
  const float* x0 = layer == 0 ? p.in[0] : p.out;
  const float* x1 = layer == 0 ? p.in[1] : p.out + (size_t)TC * D;
  float* xout = p.out;
  for (int j_ = blockIdx.x >> 3; j_ < 8 * 8; j_ += gridDim.x >> 3) {
    const int mt = (blockIdx.x & 7) * 8 + (j_ & 7), nt = j_ >> 3;
    const int m0 = mt * 192, n0 = nt * 128;
    auto epi = [=](f32x16(&acc)[2], int token, int wn, int lane) {
      const int r = lane & 31, h = lane >> 5;
      {
        const float* gate = mod + (layer * 3 + tok_group(token)) * 3072 + 2048 + n0 + wn * 64;
        const float* xi = (token < TC ? x0 + (size_t)token * D : x1 + (size_t)(token - TC) * D) + n0 + wn * 64;
        float* xo = xout + (size_t)token * D + n0 + wn * 64;
#pragma unroll
        for (int fi = 0; fi < 2; fi++)
#pragma unroll
          for (int j = 0; j < 4; j++) {
            int c = fi * 32 + h * 4 + 8 * j;
            float4 g = *(const float4*)(gate + c), x = *(const float4*)(xi + c);
            *(float4*)(xo + c) = make_float4(x.x + g.x * acc[fi][4 * j], x.y + g.y * acc[fi][4 * j + 1],
                                             x.z + g.z * acc[fi][4 * j + 2], x.w + g.w * acc[fi][4 * j + 3]);
          }
      }
    };
    gemm_tile_g192<K>(A + (size_t)m0 * K, K, W + (size_t)n0 * K, K, smem, m0, epi);
  }
}

DEV void phase_mlp_inproj(const Params& p, int mi, char* smem) {
  const bf16_t* H = (const bf16_t*)(p.ws + OFF_H);
  const bf16_t* W = (const bf16_t*)(p.ws + OFF_WIN_M) + (size_t)mi * 6144 * 1024;
  bf16_t* UZ = (bf16_t*)(p.ws + OFF_UZ);
  bf16_t* GVT = (bf16_t*)(p.ws + OFF_GVT);
  float* statv = (float*)(p.ws + OFF_STATV);
  for (int j_ = blockIdx.x >> 3; j_ < 12 * 48; j_ += gridDim.x >> 3) {
    const int mt = (blockIdx.x & 7) * 12 + j_ % 12, nt = j_ / 12;
    const int m0 = mt * 128, n0 = nt * 128;
    auto epi = [=](f32x16(&acc)[2], int token, int wn, int lane) {
      const int r = lane & 31, h = lane >> 5;
      {
        if (nt < 32) {
          bf16_t* dst = UZ + (size_t)token * 2048 + nt * 64 + wn * 32;
#pragma unroll
          for (int j = 0; j < 4; j++) {
            float v0 = gelu_f(acc[0][4 * j]) * silu_f(acc[1][4 * j]);
            float v1 = gelu_f(acc[0][4 * j + 1]) * silu_f(acc[1][4 * j + 1]);
            float v2 = gelu_f(acc[0][4 * j + 2]) * silu_f(acc[1][4 * j + 2]);
            float v3 = gelu_f(acc[0][4 * j + 3]) * silu_f(acc[1][4 * j + 3]);
            *(uint2*)(dst + h * 4 + 8 * j) = make_uint2(pack2(v0, v1), pack2(v2, v3));
          }
        } else {
          const int ch0 = (nt - 32) * 128 + wn * 64;
          bf16_t* dst = GVT + ((size_t)(token >> 7) * 2048 + ch0) * 128 + (token & 127);
          float s1 = 0.f, s2 = 0.f;
#pragma unroll
          for (int fi = 0; fi < 2; fi++)
#pragma unroll
            for (int e = 0; e < 16; e++) {
              float g = gelu_f(acc[fi][e]);
              s1 += g;
              s2 += g * g;
              int ch = fi * 32 + h * 4 + 8 * (e >> 2) + (e & 3);
              dst[(size_t)ch * 128] = f2bf(g);
            }
          s1 += __shfl_xor(s1, 32);
          s2 += __shfl_xor(s2, 32);
          if (h == 0) *(float2*)(statv + ((size_t)token * 32 + (nt - 32) * 2 + wn) * 2) = make_float2(s1, s2);
        }
      }
    };
    gemm_tile_g<1024>(H + (size_t)m0 * 64, 64, W + (size_t)n0 * 64, 64, smem, m0, epi, (size_t)T * 64, (size_t)6144 * 64);
  }
}

struct LnXf {
  const float* smu;
  const float* vg;
  const float* vb;
  DEV uint4 operator()(uint4 v, int row, int kc) const {
    const float g = vg[row], b = vb[row];
    const float* mu = smu + kc;
    const float* rs = smu + 128 + kc;
    float f0 = (bflo(v.x) - mu[0]) * rs[0] * g + b, f1 = (bfhi(v.x) - mu[1]) * rs[1] * g + b;
    float f2 = (bflo(v.y) - mu[2]) * rs[2] * g + b, f3 = (bfhi(v.y) - mu[3]) * rs[3] * g + b;
    float f4 = (bflo(v.z) - mu[4]) * rs[4] * g + b, f5 = (bfhi(v.z) - mu[5]) * rs[5] * g + b;
    float f6 = (bflo(v.w) - mu[6]) * rs[6] * g + b, f7 = (bfhi(v.w) - mu[7]) * rs[7] * g + b;
    return make_uint4(pack2(f0, f1), pack2(f2, f3), pack2(f4, f5), pack2(f6, f7));
  }
};

DEV void phase_mlp_spatial(const Params& p, int mi, char* smem) {
  const bf16_t* WS = (const bf16_t*)(p.ws + OFF_WS) + (size_t)mi * 8 * 128 * 128;
  const bf16_t* GVT = (const bf16_t*)(p.ws + OFF_GVT);
  bf16_t* UZ = (bf16_t*)(p.ws + OFF_UZ);
  const float* statv = (const float*)(p.ws + OFF_STATV);
  float* smu = (float*)(smem + 2 * 2 * 128 * 72 * 2);
  for (int t = blockIdx.x; t < 96 * 16; t += gridDim.x) {
    const int c = t >> 4, g = (t >> 1) & 7, hf = t & 1;
    if (threadIdx.x < 128) {
      const float* sp = statv + (size_t)(c * 128 + threadIdx.x) * 64;
      float s1 = 0.f, s2 = 0.f;
#pragma unroll
      for (int i = 0; i < 16; i++) {
        float4 v = *(const float4*)(sp + 4 * i);
        s1 += v.x + v.z;
        s2 += v.y + v.w;
      }
      float mu = s1 * (1.f / 2048.f);
      float var = s2 * (1.f / 2048.f) - mu * mu;
      smu[threadIdx.x] = mu;
      smu[128 + threadIdx.x] = rsqrtf(fmaxf(var, 0.f) + EPS);
    }
    __syncthreads();
    const int ch0 = g * 256 + hf * 128;
    LnXf xf{smu, p.in[16] + mi * 2048 + ch0, p.in[17] + mi * 2048 + ch0};
    const float* bs = p.in[19] + (mi * 8 + g) * 128;
    auto epi = [=](f32x16(&acc)[2], int token, int wn, int lane) {
      const int r = lane & 31, h = lane >> 5;
      {
        const int pt = token;
        const float b = bs[pt];
        bf16_t* dst = UZ + (size_t)(c * 128 + pt) * 2048 + ch0 + wn * 64;
#pragma unroll
        for (int fi = 0; fi < 2; fi++)
#pragma unroll
          for (int j = 0; j < 4; j++) {
            bf16_t* ap = dst + fi * 32 + h * 4 + 8 * j;
            uint2 u = *(const uint2*)ap;
            float v0 = bflo(u.x) * (acc[fi][4 * j] + b), v1 = bfhi(u.x) * (acc[fi][4 * j + 1] + b);
            float v2 = bflo(u.y) * (acc[fi][4 * j + 2] + b), v3 = bfhi(u.y) * (acc[fi][4 * j + 3] + b);
            *(uint2*)ap = make_uint2(pack2(v0, v1), pack2(v2, v3));
          }
      }
    };
    gemm_tile<128>(WS + (size_t)g * 128 * 128, 128, GVT + ((size_t)c * 2048 + ch0) * 128, 128, smem, 0, epi, xf);
  }
}

DEV void phase_final(const Params& p) {
  const int tid_ = opaque_tid(); const int lane = tid_ & 63, w = tid_ >> 6;
  const float* fg = p.in[21];
  for (int row = blockIdx.x * 4 + w; row < T; row += gridDim.x * 4) {
    float* xr = p.out + (size_t)row * D;
    float4 v[4];
    float ss = 0.f;
#pragma unroll
    for (int i = 0; i < 4; i++) {
      v[i] = *(const float4*)(xr + i * 256 + lane * 4);
      ss += v[i].x * v[i].x + v[i].y * v[i].y + v[i].z * v[i].z + v[i].w * v[i].w;
    }
    ss = wave_sum(ss);
    const float rstd = rsqrtf(ss * (1.f / 1024.f) + EPS);
#pragma unroll
    for (int i = 0; i < 4; i++) {
      int c = i * 256 + lane * 4;
      float4 g = *(const float4*)(fg + c);
      *(float4*)(xr + c) = make_float4(v[i].x * rstd * g.x, v[i].y * rstd * g.y, v[i].z * rstd * g.z, v[i].w * rstd * g.w);
    }
  }
}

#define XB_TMO      128
#define XB_XCNT(j)  (256  + 64 * (j))
#define XB_XSUB(j)  (1280 + 64 * (j))
#define XB_XGEN(j)  (2304 + 64 * (j))
#define XB_TOP      3328
#define XB_TOPGEN   3392
#define XCD_BAR_WORDS 3456
#define XB_SPIN_CAP (1u << 18)
#define LAS __attribute__((address_space(3)))

__device__ __forceinline__ unsigned xb_ld(unsigned* p)              { return __hip_atomic_load(p, __ATOMIC_RELAXED, __HIP_MEMORY_SCOPE_AGENT); }
__device__ __forceinline__ unsigned xb_add(unsigned* p, unsigned v) { return __hip_atomic_fetch_add(p, v, __ATOMIC_RELAXED, __HIP_MEMORY_SCOPE_AGENT); }
__device__ __forceinline__ unsigned xb_xcc_id() { return (unsigned)__builtin_amdgcn_s_getreg((3 << 11) | 20) & 0xFu; }
#define XB_SPIN(cond, bar) do { unsigned _sp = 0; while (cond) { __builtin_amdgcn_s_sleep(1); \
    if ((++_sp & 255u) == 0u) { if (xb_ld(&(bar)[XB_TMO])) break; if (_sp > XB_SPIN_CAP) { atomicAdd(&(bar)[XB_TMO], 1u); break; } } } } while (0)

struct XcdBarrier {
    unsigned* bar; unsigned x;
    volatile LAS unsigned* st;
};

__device__ __forceinline__ XcdBarrier xcd_barrier_post(unsigned* bar, volatile LAS unsigned* st) {
    XcdBarrier b; b.bar = bar; b.x = xb_xcc_id(); b.st = st;
    if (threadIdx.x == 0) (void)xb_add(&bar[XB_XCNT(b.x)], 1u);
    return b;
}
__device__ __forceinline__ void xcd_barrier_complete(unsigned* bar, unsigned x, unsigned& nloc, unsigned& nx) {
    const unsigned G = gridDim.x * gridDim.y * gridDim.z;
    unsigned sum, cnt, mine, sp = 0u;
    for (;;) {
        sum = 0u; cnt = 0u; mine = 0u;
#pragma unroll
        for (unsigned j = 0; j < 16; ++j) { const unsigned c = xb_ld(&bar[XB_XCNT(j)]); sum += c; cnt += (c > 0u) ? 1u : 0u; mine = (j == x) ? c : mine; }
        if (sum == G) break;
        __builtin_amdgcn_s_sleep(1);
        if ((++sp & 255u) == 0u) { if (xb_ld(&bar[XB_TMO])) break; if (sp > XB_SPIN_CAP) { atomicAdd(&bar[XB_TMO], 1u); break; } }
    }
    nloc = mine > 0u ? mine : 1u; nx = cnt > 0u ? cnt : 1u;
}

__device__ __forceinline__ void xcd_barrier(const XcdBarrier& b) {
    asm volatile("s_waitcnt vmcnt(0)" ::: "memory");
    __syncthreads();
    if (threadIdx.x == 0) {
        unsigned* bar = b.bar;
        __builtin_amdgcn_s_waitcnt(0);
        unsigned nloc = b.st[0], nx = b.st[1];
        if (nloc == 0u) { xcd_barrier_complete(bar, b.x, nloc, nx); b.st[0] = nloc; b.st[1] = nx; }
        const unsigned old = xb_add(&bar[XB_XSUB(b.x)], 1u);
        const unsigned gen = old / nloc;
        if (old + 1u == (gen + 1u) * nloc) {
            __builtin_amdgcn_fence(__ATOMIC_RELEASE, "agent");
            asm volatile("s_waitcnt vmcnt(0)" ::: "memory");
            const unsigned og = xb_add(&bar[XB_TOP], 1u);
            const unsigned tg = og / nx;
            if (og + 1u == (tg + 1u) * nx) xb_add(&bar[XB_TOPGEN], 1u);
            else XB_SPIN(xb_ld(&bar[XB_TOPGEN]) == tg, bar);
            __builtin_amdgcn_fence(__ATOMIC_ACQUIRE, "agent");
            xb_add(&bar[XB_XGEN(b.x)], 1u);
            asm volatile("s_waitcnt vmcnt(0)" ::: "memory");
        } else {
            XB_SPIN(xb_ld(&bar[XB_XGEN(b.x)]) == gen, bar);
            __builtin_amdgcn_fence(__ATOMIC_ACQUIRE, "agent");
            asm volatile("s_waitcnt vmcnt(0)" ::: "memory");
        }
    }
    __syncthreads();
}


__global__ void __launch_bounds__(256, 2) fwd_megakernel(Params p) {
  extern __shared__ __attribute__((aligned(16))) char smem[];
  cg::grid_group grid = cg::this_grid();
  volatile LAS unsigned* xb_st = (volatile LAS unsigned*)(smem + LDS_MAIN);
  if (threadIdx.x == 0) { xb_st[0] = 0u; xb_st[1] = 0u; xb_st[2] = 0u; xb_st[3] = 0u; }
  __syncthreads();
  XcdBarrier xb = xcd_barrier_post((unsigned*)(p.ws + OFF_BAR), xb_st);
  if (p.lo < 0) grid.sync();
  int pc = 0;
#define PHASE(body)                         \
  {                                         \
    if (pc >= p.lo && pc < p.hi) {          \
      body;                                 \
      if (pc + 1 < p.hi) xcd_barrier(xb);   \
    }                                       \
    pc++;                                   \
  }
  PHASE(phase_prep(p, smem));
#pragma unroll 1
  for (int layer = 0; layer < 4; layer++) {
    const int a = layer >> 1;
    PHASE(phase_prenorm(p, layer));
    if ((layer & 1) == 0) {
      PHASE(phase_attn_inproj(p, layer, a, smem));
      PHASE(phase_attn_up(p, layer, a, smem));
      PHASE(phase_attn_core(p, a, smem));
      PHASE(phase_outproj<1024>(p, layer, (const bf16_t*)(p.ws + OFF_ZS),
                          (const bf16_t*)(p.ws + OFF_WO_A) + (size_t)a * 1024 * 1024, smem));
    } else {
      PHASE(phase_mlp_inproj(p, a, smem));
      PHASE(phase_mlp_spatial(p, a, smem));
      PHASE(phase_outproj<2048>(p, layer, (const bf16_t*)(p.ws + OFF_UZ),
                          (const bf16_t*)(p.ws + OFF_WO_M) + (size_t)a * 1024 * 2048, smem));
    }
  }
  PHASE(phase_final(p));
}

extern "C" void kernel_launch(void* const* d_in, const int* in_sizes, int n_in, void* d_out, int out_size, void* d_ws,
                              size_t ws_size, hipStream_t stream) {
  static int grid_blocks = 0;
  if (!grid_blocks) {
    hipFuncSetAttribute((const void*)fwd_megakernel, hipFuncAttributeMaxDynamicSharedMemorySize, LDS_BYTES);
    int dev = 0, cus = 0, per_cu = 0;
    hipGetDevice(&dev);
    hipDeviceGetAttribute(&cus, hipDeviceAttributeMultiprocessorCount, dev);
    hipOccupancyMaxActiveBlocksPerMultiprocessor(&per_cu, fwd_megakernel, 256, LDS_BYTES);
    if (per_cu > 2) per_cu = 2;
    if (per_cu < 1) per_cu = 1;
    grid_blocks = cus * per_cu;
  }
  Params p{};
  for (int i = 0; i < 22; i++) p.in[i] = (const float*)d_in[i];
  p.out = (float*)d_out;
  p.ws = (char*)d_ws;
  p.lo = 0;
  p.hi = 1000;
  hipMemsetAsync((char*)d_ws + OFF_BAR, 0, 16384 + SZ_MOD, stream);
  void* args[] = {&p};
  hipError_t e = hipLaunchCooperativeKernel((void*)fwd_megakernel, dim3(grid_blocks), dim3(256), args, LDS_BYTES, stream);
  if (e != hipSuccess) fprintf(stderr, "cooperative launch failed: %s (grid %d)\n", hipGetErrorString(e), grid_blocks);
}
```
